# Optimizing an MI355X kernel written in HIP

```python
import math
import jax, jax.numpy as jnp
from jax import lax
import numpy as np


D_MODEL = 2048
BATCH = 1
SEQ = 8192
DEPTH = 2

GRID_W = 64
CTX_LEN = 256
BLK = 128
SSD_HEADS = 16
SSD_HEADDIM = 64
SSD_INNER = SSD_HEADS * SSD_HEADDIM
SSD_STATE = 128
SSD_GROUPS = 2
SSD_CONV = 5
SSD_CHUNK = 128
SSD_XBC = SSD_INNER + 2 * SSD_GROUPS * SSD_STATE
HEAD_DIM = 64
WIN_QH = 8
WIN_KVH = 2
WINDOW = 128
ROPE_BASE = 10000.0
NAT_HEADS = 8
NAT_ROWS = 8
NAT_COLS = 16
MIX_WIDTH = SSD_INNER + WIN_QH * HEAD_DIM + NAT_HEADS * HEAD_DIM
IN_SIZES = (SSD_INNER, SSD_XBC, 2 * SSD_HEADS, WIN_QH * HEAD_DIM, WIN_KVH * HEAD_DIM, WIN_KVH * HEAD_DIM, NAT_HEADS * HEAD_DIM, NAT_HEADS * HEAD_DIM, NAT_HEADS * HEAD_DIM)
IN_WIDTH = sum(IN_SIZES)
PEER_HEADS = 8
PEER_KEYS = 128
PEER_EXPERTS = PEER_KEYS * PEER_KEYS
PEER_TOPK = 16
PEER_DK = 256
LN_EPS = 1e-6

kernel_name = 'hybrid_ssd_swa_natten_peer_diffusion_block'


def layer_norm(x, g, b):
    xf = x.astype(jnp.float32)
    mu = jnp.mean(xf, -1, keepdims=True)
    var = jnp.mean(jnp.square(xf - mu), -1, keepdims=True)
    return ((xf - mu) * lax.rsqrt(var + LN_EPS) * g.astype(jnp.float32) + b.astype(jnp.float32)).astype(x.dtype)


def rms_norm(x, g):
    xf = x.astype(jnp.float32)
    return (xf * lax.rsqrt(jnp.mean(jnp.square(xf), -1, keepdims=True) + LN_EPS) * g.astype(jnp.float32)).astype(x.dtype)


def depthwise_conv(u, w, b):
    k = w.shape[1]
    rhs = w.T[:, None, :]
    y = lax.conv_general_dilated(u, rhs, (1,), [(k // 2, k // 2)], dimension_numbers=('NWC', 'WIO', 'NWC'), feature_group_count=u.shape[-1])
    return y + b


def axial_rope(t, rows, cols):
    dh = t.shape[-1]
    half = dh // 2
    nf = half // 2
    inv = ROPE_BASE ** (-jnp.arange(nf, dtype=jnp.float32) / nf)

    def rot(part, pos):
        ang = pos.astype(jnp.float32)[:, None] * inv[None, :]
        cos = jnp.cos(ang)[None, :, None, :].astype(t.dtype)
        sin = jnp.sin(ang)[None, :, None, :].astype(t.dtype)
        p1, p2 = part[..., :nf], part[..., nf:]
        return jnp.concatenate([p1 * cos - p2 * sin, p1 * sin + p2 * cos], -1)

    return jnp.concatenate([rot(t[..., :half], rows), rot(t[..., half:], cols)], -1)


def ssd_chunked(xs, dt, a, bm, cm, h0, with_y):
    bsz, t_len, nh, hp = xs.shape
    ng, ns = bm.shape[2], bm.shape[3]
    q = SSD_CHUNK
    nc = t_len // q
    bh = jnp.repeat(bm.astype(jnp.float32), nh // ng, axis=2).reshape(bsz, nc, q, nh, ns)
    ch = jnp.repeat(cm.astype(jnp.float32), nh // ng, axis=2).reshape(bsz, nc, q, nh, ns)
    xdt = (xs.astype(jnp.float32) * dt[..., None]).reshape(bsz, nc, q, nh, hp)
    a_cs = jnp.cumsum((dt * a).reshape(bsz, nc, q, nh).transpose(0, 3, 1, 2), axis=-1)
    decay_to_end = jnp.exp(a_cs[..., -1:] - a_cs)
    states = jnp.einsum('bclhn,bhcl,bclhp->bchpn', bh, decay_to_end, xdt)
    chunk_decay = jnp.exp(a_cs[..., -1])

    def step(h, inp):
        dec, st = inp
        return dec[..., None, None] * h + st, h

    h_final, h_prev = lax.scan(step, h0, (chunk_decay.transpose(2, 0, 1), states.transpose(1, 0, 2, 3, 4)))
    if not with_y:
        return None, h_final
    h_prev = h_prev.transpose(1, 0, 2, 3, 4)
    idx = jnp.arange(q)
    lower = idx[:, None] >= idx[None, :]
    seg = a_cs[..., :, None] - a_cs[..., None, :]
    lmat = jnp.exp(jnp.where(lower, seg, -jnp.inf))
    y_diag = jnp.einsum('bclhn,bcshn,bhcls,bcshp->bclhp', ch, bh, lmat, xdt)
    y_off = jnp.einsum('bclhn,bchpn,bhcl->bclhp', ch, h_prev, jnp.exp(a_cs))
    return (y_diag + y_off).reshape(bsz, t_len, nh, hp), h_final


def ssd_mixer(z, xbc, dt, zc, xbcc, dtc, conv_w, conv_b, dt_bias, a_log, d_skip, norm_w, need_ctx):
    a = -jnp.exp(a_log.astype(jnp.float32))
    dtb = dt_bias.astype(jnp.float32).reshape(-1)
    flip = lambda t: jnp.flip(t, axis=1)

    def prep(u, dt_raw):
        u = jax.nn.silu(depthwise_conv(u, conv_w, conv_b))
        bsz, t_len = u.shape[0], u.shape[1]
        xs, bm, cm = jnp.split(u, [SSD_INNER, SSD_INNER + SSD_GROUPS * SSD_STATE], axis=-1)
        d = jax.nn.softplus(dt_raw.astype(jnp.float32) + dtb)
        return (xs.reshape(bsz, t_len, SSD_HEADS, SSD_HEADDIM), bm.reshape(bsz, t_len, SSD_GROUPS, SSD_STATE),
                cm.reshape(bsz, t_len, SSD_GROUPS, SSD_STATE), d[..., :SSD_HEADS], d[..., SSD_HEADS:])

    def bidir(xs, bm, cm, dtf, dtr, hf0, hb0, with_y):
        yf, hf = ssd_chunked(xs, dtf, a[0], bm, cm, hf0, with_y)
        yb, hb = ssd_chunked(flip(xs), flip(dtr), a[1], flip(bm), flip(cm), hb0, with_y)
        return yf, yb, hf, hb

    def finish(xs, yf, yb, zz):
        bsz, t_len = xs.shape[0], xs.shape[1]
        y = yf + flip(yb) + d_skip.astype(jnp.float32)[:, None] * xs.astype(jnp.float32)
        y = y.reshape(bsz, t_len, SSD_INNER).astype(zz.dtype)
        return rms_norm(y * jax.nn.silu(zz), norm_w)

    ctx_in = prep(xbcc, dtc)
    h0 = jnp.zeros((xbcc.shape[0], SSD_HEADS, SSD_HEADDIM, SSD_STATE), jnp.float32)
    ycf, ycb, hf, hb = bidir(*ctx_in, h0, h0, need_ctx)
    lat_in = prep(xbc, dt)
    yf, yb, _, _ = bidir(*lat_in, hf, hb, True)
    y = finish(lat_in[0], yf, yb, z)
    yc = finish(ctx_in[0], ycf, ycb, zc) if need_ctx else None
    return y, yc


def window_gqa(q, k, v, kc, vc, sink):
    bsz, t_len, hq, dh = q.shape
    hkv = k.shape[2]
    g = hq // hkv
    nb = t_len // BLK
    scale = dh ** -0.5
    qb = q.reshape(bsz, nb, BLK, hkv, g, dh)

    def bands(t):
        tp = jnp.pad(t, ((0, 0), (BLK, BLK), (0, 0), (0, 0))).reshape(bsz, nb + 2, BLK, hkv, dh)
        return jnp.concatenate([tp[:, :-2], tp[:, 1:-1], tp[:, 2:]], axis=2)

    kw, vw = bands(k), bands(v)
    qi = jnp.arange(BLK)[:, None]
    kj = jnp.arange(3 * BLK)[None, :] - BLK
    kabs = jnp.arange(nb)[:, None, None] * BLK + kj[None]
    mask = (jnp.abs(kj - qi) <= WINDOW)[None] & (kabs >= 0) & (kabs < t_len)
    s_loc = jnp.einsum('bnqhgd,bnkhd->bnhgqk', qb, kw).astype(jnp.float32) * scale
    s_loc = jnp.where(mask[None, :, None, None], s_loc, -jnp.inf)
    s_ctx = jnp.einsum('bnqhgd,bkhd->bnhgqk', qb, kc).astype(jnp.float32) * scale
    sink_col = jnp.broadcast_to(sink.astype(jnp.float32).reshape(1, 1, hkv, g, 1, 1), s_loc.shape[:-1] + (1,))
    p = jax.nn.softmax(jnp.concatenate([s_loc, s_ctx, sink_col], -1), axis=-1).astype(q.dtype)
    nloc = 3 * BLK
    nctx = kc.shape[1]
    o = jnp.einsum('bnhgqk,bnkhd->bnqhgd', p[..., :nloc], vw) + jnp.einsum('bnhgqk,bkhd->bnqhgd', p[..., nloc:nloc + nctx], vc)
    return o.reshape(bsz, t_len, hq * dh)


def ctx_attention(qc, kc, vc, sink):
    bsz, tc, hq, dh = qc.shape
    hkv = kc.shape[2]
    g = hq // hkv
    qg = qc.reshape(bsz, tc, hkv, g, dh)
    s = jnp.einsum('bqhgd,bkhd->bhgqk', qg, kc).astype(jnp.float32) * dh ** -0.5
    if sink is not None:
        s = jnp.concatenate([s, jnp.broadcast_to(sink.astype(jnp.float32).reshape(1, hkv, g, 1, 1), s.shape[:-1] + (1,))], -1)
    p = jax.nn.softmax(s, axis=-1)[..., :kc.shape[1]].astype(qc.dtype)
    return jnp.einsum('bhgqk,bkhd->bqhgd', p, vc).reshape(bsz, tc, hq * dh)


def neighbourhood_index(t_len):
    n_rows = t_len // GRID_W
    kr = min(NAT_ROWS, n_rows)
    t = jnp.arange(t_len)
    r = t // GRID_W
    col = t % GRID_W
    rs = jnp.clip(r - kr // 2, 0, n_rows - kr)
    cs = jnp.clip(col - NAT_COLS // 2, 0, GRID_W - NAT_COLS)
    key_r = rs[:, None, None] + jnp.arange(kr)[None, :, None]
    key_c = cs[:, None, None] + jnp.arange(NAT_COLS)[None, None, :]
    shape = (t_len, kr, NAT_COLS)
    idx = jnp.broadcast_to(key_r * GRID_W + key_c, shape).reshape(t_len, -1)
    dr = jnp.broadcast_to(key_r - r[:, None, None], shape).reshape(t_len, -1)
    dc = jnp.broadcast_to(key_c - col[:, None, None], shape).reshape(t_len, -1)
    return idx, dr, dc


def neighbourhood_attn(q, k, v, kc, vc, rpb):
    bsz, t_len, nh, dh = q.shape
    nb = t_len // BLK
    scale = dh ** -0.5
    idx, dr, dc = neighbourhood_index(t_len)
    nk = idx.shape[-1]

    def block(args):
        qb, ib, drb, dcb = args
        kg = k[:, ib]
        vg = v[:, ib]
        bias = rpb[:, drb + NAT_ROWS - 1, dcb + NAT_COLS - 1].astype(jnp.float32)
        s_n = jnp.einsum('bqhd,bqkhd->bhqk', qb, kg).astype(jnp.float32) * scale + bias[None]
        s_c = jnp.einsum('bqhd,bkhd->bhqk', qb, kc).astype(jnp.float32) * scale
        p = jax.nn.softmax(jnp.concatenate([s_n, s_c], -1), axis=-1).astype(qb.dtype)
        return jnp.einsum('bhqk,bqkhd->bqhd', p[..., :nk], vg) + jnp.einsum('bhqk,bkhd->bqhd', p[..., nk:], vc)

    qs = q.reshape(bsz, nb, BLK, nh, dh).transpose(1, 0, 2, 3, 4)
    o = lax.map(block, (qs, idx.reshape(nb, BLK, nk), dr.reshape(nb, BLK, nk), dc.reshape(nb, BLK, nk)))
    return o.transpose(1, 0, 2, 3, 4).reshape(bsz, t_len, nh * dh)


def mix_tokens(h, hc, rows, cols, w_in, conv_w, conv_b, dt_bias, a_log, d_skip, norm_w, sink, rpb, w_out, need_ctx):
    offs = np.cumsum(IN_SIZES)[:-1].tolist()
    z, xbc, dt, wq, wk, wv, nq, nk, nv = jnp.split(h @ w_in, offs, axis=-1)
    zc, xbcc, dtc, wqc, wkc, wvc, nqc, nkc, nvc = jnp.split(hc @ w_in, offs, axis=-1)
    heads = lambda t, n: t.reshape(t.shape[0], t.shape[1], n, HEAD_DIM)
    y_ssd, yc_ssd = ssd_mixer(z, xbc, dt, zc, xbcc, dtc, conv_w, conv_b, dt_bias, a_log, d_skip, norm_w, need_ctx)
    q = axial_rope(heads(wq, WIN_QH), rows, cols)
    k = axial_rope(heads(wk, WIN_KVH), rows, cols)
    v = heads(wv, WIN_KVH)
    kc_w, vc_w = heads(wkc, WIN_KVH), heads(wvc, WIN_KVH)
    y_win = window_gqa(q, k, v, kc_w, vc_w, sink)
    kc_n, vc_n = heads(nkc, NAT_HEADS), heads(nvc, NAT_HEADS)
    y_nat = neighbourhood_attn(heads(nq, NAT_HEADS), heads(nk, NAT_HEADS), heads(nv, NAT_HEADS), kc_n, vc_n, rpb)
    y = jnp.concatenate([y_ssd, y_win, y_nat], -1) @ w_out
    if not need_ctx:
        return y, None
    yc_win = ctx_attention(heads(wqc, WIN_QH), kc_w, vc_w, sink)
    yc_nat = ctx_attention(heads(nqc, NAT_HEADS), kc_n, vc_n, None)
    yc = jnp.concatenate([yc_ssd, yc_win, yc_nat], -1) @ w_out
    return y, yc


def peer_ffn(h, wq, k1, k2, u, v):
    bsz, t_len, d = h.shape
    half = PEER_DK // 2
    q = (h @ wq).reshape(bsz, t_len, PEER_HEADS, PEER_DK)
    s1 = jnp.einsum('bthd,nd->bthn', q[..., :half], k1).astype(jnp.float32)
    s2 = jnp.einsum('bthd,nd->bthn', q[..., half:], k2).astype(jnp.float32)
    v1, i1 = lax.top_k(s1, PEER_TOPK)
    v2, i2 = lax.top_k(s2, PEER_TOPK)
    cand = (v1[..., :, None] + v2[..., None, :]).reshape(bsz, t_len, PEER_HEADS, PEER_TOPK * PEER_TOPK)
    cidx = (i1[..., :, None] * PEER_KEYS + i2[..., None, :]).reshape(bsz, t_len, PEER_HEADS, PEER_TOPK * PEER_TOPK)
    top_s, pos = lax.top_k(cand, PEER_TOPK)
    eidx = jnp.take_along_axis(cidx, pos, axis=-1)
    gate = jax.nn.softmax(top_s, axis=-1).astype(h.dtype)
    nblk = bsz * t_len // BLK

    def block(args):
        hb, eb, gb = args
        act = jax.nn.gelu(jnp.einsum('thkd,td->thk', u[eb], hb), approximate=False)
        return jnp.einsum('thk,thkd->td', gb * act, v[eb])

    out = lax.map(block, (h.reshape(nblk, BLK, d), eidx.reshape(nblk, BLK, PEER_HEADS, PEER_TOPK), gate.reshape(nblk, BLK, PEER_HEADS, PEER_TOPK)))
    return out.reshape(bsz, t_len, d)


def setup_inputs(seed: int = 0) -> dict:
    key = jax.random.key(seed)
    ks = jax.random.split(key, 26)
    f32 = jnp.float32
    beta = (8.0 * DEPTH) ** -0.25
    nl = DEPTH

    def nrm(k, shape, s):
        return jax.random.normal(k, shape, f32) * s

    dt0 = jnp.exp(jax.random.uniform(ks[9], (nl, 2, SSD_HEADS), f32, math.log(1e-3), math.log(1e-1)))
    return {
        'x': nrm(ks[0], (BATCH, SEQ, D_MODEL), 1.0),
        'c': nrm(ks[1], (BATCH, D_MODEL), 1.0),
        'ctx': nrm(ks[2], (BATCH, CTX_LEN, D_MODEL), 1.0),
        'c_ctx': nrm(ks[3], (D_MODEL,), 1.0),
        'w_ada': nrm(ks[4], (nl, D_MODEL, 6 * D_MODEL), 0.5 * D_MODEL ** -0.5),
        'b_ada': nrm(ks[5], (nl, 6 * D_MODEL), 0.01),
        'w_in': nrm(ks[6], (nl, D_MODEL, IN_WIDTH), D_MODEL ** -0.5),
        'ssd_conv_w': nrm(ks[7], (nl, SSD_XBC, SSD_CONV), SSD_CONV ** -0.5),
        'ssd_conv_b': nrm(ks[8], (nl, SSD_XBC), 0.01),
        'ssd_dt_bias': dt0 + jnp.log(-jnp.expm1(-dt0)),
        'ssd_a_log': jnp.log(jax.random.uniform(ks[10], (nl, 2, SSD_HEADS), f32, 1.0, 16.0)),
        'ssd_d': 1.0 + nrm(ks[11], (nl, SSD_HEADS), 0.05),
        'ssd_norm_w': 1.0 + nrm(ks[12], (nl, SSD_INNER), 0.05),
        'attn_sink': nrm(ks[13], (nl, WIN_QH), 0.5),
        'nat_rpb': nrm(ks[14], (nl, NAT_HEADS, 2 * NAT_ROWS - 1, 2 * NAT_COLS - 1), 0.02),
        'w_out': nrm(ks[15], (nl, MIX_WIDTH, D_MODEL), beta * MIX_WIDTH ** -0.5),
        'ln1_g': 1.0 + nrm(ks[16], (nl, D_MODEL), 0.05),
        'ln1_b': nrm(ks[17], (nl, D_MODEL), 0.01),
        'peer_wq': nrm(ks[18], (nl, D_MODEL, PEER_HEADS * PEER_DK), D_MODEL ** -0.5),
        'peer_k1': nrm(ks[19], (nl, PEER_KEYS, PEER_DK // 2), (PEER_DK // 2) ** -0.5),
        'peer_k2': nrm(ks[20], (nl, PEER_KEYS, PEER_DK // 2), (PEER_DK // 2) ** -0.5),
        'peer_u': nrm(ks[21], (nl, PEER_EXPERTS, D_MODEL), D_MODEL ** -0.5),
        'peer_v': nrm(ks[22], (nl, PEER_EXPERTS, D_MODEL), beta),
        'ln2_g': 1.0 + nrm(ks[23], (nl, D_MODEL), 0.05),
        'ln2_b': nrm(ks[24], (nl, D_MODEL), 0.01),
    }


def reference(x, c, ctx, c_ctx, w_ada, b_ada, w_in, ssd_conv_w, ssd_conv_b, ssd_dt_bias, ssd_a_log, ssd_d, ssd_norm_w, attn_sink, nat_rpb, w_out, ln1_g, ln1_b, peer_wq, peer_k1, peer_k2, peer_u, peer_v, ln2_g, ln2_b):
    alpha = (2.0 * DEPTH) ** 0.25
    t_len = x.shape[1]
    pos = jnp.arange(t_len)
    rows, cols = pos // GRID_W, pos % GRID_W
    cx = ctx
    for l in range(DEPTH):
        need_ctx = l < DEPTH - 1
        mod = jax.nn.silu(c) @ w_ada[l] + b_ada[l]
        mod_c = jax.nn.silu(c_ctx) @ w_ada[l] + b_ada[l]
        sh1, sc1, g1, sh2, sc2, g2 = jnp.split(mod[:, None, :], 6, axis=-1)
        csh1, csc1, cg1, csh2, csc2, cg2 = jnp.split(mod_c, 6, axis=-1)
        h = x * (1.0 + sc1) + sh1
        hc = cx * (1.0 + csc1) + csh1
        y, yc = mix_tokens(h, hc, rows, cols, w_in[l], ssd_conv_w[l], ssd_conv_b[l], ssd_dt_bias[l], ssd_a_log[l], ssd_d[l], ssd_norm_w[l], attn_sink[l], nat_rpb[l], w_out[l], need_ctx)
        x = layer_norm(alpha * x + g1 * y, ln1_g[l], ln1_b[l])
        f = peer_ffn(x * (1.0 + sc2) + sh2, peer_wq[l], peer_k1[l], peer_k2[l], peer_u[l], peer_v[l])
        x = layer_norm(alpha * x + g2 * f, ln2_g[l], ln2_b[l])
        if need_ctx:
            cx = layer_norm(alpha * cx + cg1 * yc, ln1_g[l], ln1_b[l])
            fc = peer_ffn(cx * (1.0 + csc2) + csh2, peer_wq[l], peer_k1[l], peer_k2[l], peer_u[l], peer_v[l])
            cx = layer_norm(alpha * cx + cg2 * fc, ln2_g[l], ln2_b[l])
    return x
```

```cpp
#include <hip/hip_runtime.h>
#include <hip/hip_cooperative_groups.h>
#include <cstdint>
#include <cstdio>
namespace cg = cooperative_groups;

#define LAS __attribute__((address_space(3)))
typedef short bf16x8 __attribute__((ext_vector_type(8)));
typedef short s16x4 __attribute__((ext_vector_type(4)));
typedef float f32x4 __attribute__((ext_vector_type(4)));
typedef float f32x2 __attribute__((ext_vector_type(2)));
typedef unsigned u32x4 __attribute__((ext_vector_type(4)));
typedef unsigned u32x2 __attribute__((ext_vector_type(2)));
typedef unsigned short bf16_t;

constexpr int DM = 2048, SEQ = 8192, CTXL = 256, TOK = SEQ + CTXL;
constexpr int NPROJ = 5120;
constexpr int C_Z = 0, C_XBC = 1024, C_WQ = 2560, C_WK = 3072, C_WV = 3200, C_NQ = 3328, C_NK = 3840, C_NV = 4352, C_DT = 4864;
constexpr int IN_W = 4896;
constexpr int MO_SH1 = 0, MO_SC1 = 2048, MO_G1 = 4096, MO_SH2 = 6144, MO_SC2 = 8192, MO_G2 = 10240, MODW = 12288;
constexpr int NCH = 66;
constexpr float LN_EPS = 1e-6f;
constexpr float ALPHA = 1.4142135623730951f;
constexpr float LOG2E = 1.4426950408889634f;
constexpr float QK_SCALE = 0.125f * LOG2E;
constexpr int NEXP = 16384;

constexpr size_t MiB = 1u << 20;
constexpr size_t WS_CTL = 0;
constexpr size_t WS_MOD = 1 * MiB;
constexpr size_t WS_ROPE = 1 * MiB + 512 * 1024;
constexpr size_t WS_WIN = 2 * MiB;
constexpr size_t WS_WOUT = 42 * MiB;
constexpr size_t WS_WQ = 58 * MiB;
constexpr size_t WS_PK = 74 * MiB;
constexpr size_t WS_U = 76 * MiB;
constexpr size_t WS_V = 204 * MiB;
constexpr size_t WS_X = 332 * MiB;
constexpr size_t WS_H = 398 * MiB;
constexpr size_t WS_PROJ = 432 * MiB;
constexpr size_t WS_XBC = 516 * MiB;
constexpr size_t WS_XBCT = 542 * MiB;
constexpr size_t WS_VT = 568 * MiB;
constexpr size_t WS_DT = 580 * MiB;
constexpr size_t WS_ACS = 582 * MiB;
constexpr size_t WS_STATES = 584 * MiB;
constexpr size_t WS_CDEC = 650 * MiB;
constexpr size_t WS_YG = 651 * MiB;
constexpr size_t WS_SSQ = 668 * MiB;
constexpr size_t WS_MIX = 670 * MiB;
constexpr size_t WS_R = 704 * MiB;
constexpr size_t WS_Q = 770 * MiB;
constexpr size_t WS_EIDX = 804 * MiB;
constexpr size_t WS_GATE = 809 * MiB;
constexpr size_t WS_HPREV = 814 * MiB;
constexpr size_t WS_END = 880 * MiB;

struct Params {
    const float *x, *c, *ctx, *c_ctx, *w_ada, *b_ada, *w_in, *conv_w, *conv_b, *dt_bias, *a_log, *ssd_d, *norm_w, *sink, *rpb, *w_out,
                *ln1_g, *ln1_b, *peer_wq, *k1, *k2, *peer_u, *peer_v, *ln2_g, *ln2_b;
    float* out; unsigned char* ws;
};

typedef const __attribute__((address_space(4))) Params* KP;

__device__ __forceinline__ unsigned pk2(float lo, float hi) { typedef __bf16 b2 __attribute__((ext_vector_type(2))); f32x2 v = {lo, hi}; b2 b = __builtin_convertvector(v, b2); return __builtin_bit_cast(unsigned, b); }
__device__ __forceinline__ float bflo(unsigned u) { return __uint_as_float(u << 16); }
__device__ __forceinline__ float bfhi(unsigned u) { return __uint_as_float(u & 0xffff0000u); }
__device__ __forceinline__ float bf1(bf16_t u) { return __uint_as_float(((unsigned)u) << 16); }
__device__ __forceinline__ bf16_t f2bf(float f) { return (bf16_t)(pk2(f, 0.f) & 0xffffu); }
__device__ __forceinline__ float wave_sum(float v) {
#pragma unroll
    for (int o = 32; o >= 1; o >>= 1) v += __shfl_xor(v, o);
    return v;
}
__device__ __forceinline__ float fexp2(float x) { return __builtin_amdgcn_exp2f(x); }
__device__ __forceinline__ float sigmoidf_(float v) { return 1.f / (1.f + __expf(-v)); }
#define LDS_WAIT() asm volatile("s_waitcnt lgkmcnt(0)" ::: "memory")

namespace pg8 {
#define PG8_LAS __attribute__((address_space(3)))
typedef unsigned short bf16_t;
typedef short bf16x8 __attribute__((ext_vector_type(8)));
typedef float f32x4 __attribute__((ext_vector_type(4)));
typedef unsigned u32x4 __attribute__((ext_vector_type(4)));
constexpr int BM = 256, BK = 64, HALF = 128, HTB = HALF * BK * 2  , STAGE_BYTES = 8 * HTB, NXCD = 8, WGM = 8;

__host__ __device__ __forceinline__ int lds_byte(int r, int c) { const int st = (r >> 4) * 2 + (c >> 5), rr = r & 15, cc = c & 31, ob = rr * 64 + cc * 2; return st * 1024 + (ob ^ (((ob >> 9) & 1) << 5)); }
__host__ __device__ __forceinline__ void stage_rc(int b, int& R, int& C) { const int st = b / 1024, sb = b % 1024, swz = sb ^ (((sb >> 9) & 1) << 5); R = (st >> 1) * 16 + swz / 64; C = (st & 1) * 32 + (swz % 64) / 2; }
__host__ __device__ __forceinline__ int perm32(int rho) { const int n = rho >> 4, i = rho & 15; return 8 * (i >> 2) + 4 * n + (i & 3); }

struct Unit { int pm, pn; };
struct Gemm { const bf16_t* A; const bf16_t* Bt; int M, N, K; };

struct StaticOrder {
    int nM, nN, nwg, G, c;
    __host__ __device__ void init(int M, int N, int G_, int c_) { nM = M / BM; nN = N / BM; nwg = nM * nN; G = G_; c = c_; }
    __host__ __device__ bool next(int i, Unit& u) const {
        const long L = (long)i * G + c; if (L >= nwg) return false;
        int wgid = (int)L; { const int q = nwg / NXCD, r = nwg % NXCD, xcd = wgid % NXCD, off = wgid / NXCD; wgid = (xcd < r ? xcd * (q + 1) : r * (q + 1) + (xcd - r) * q) + off; }
        const int nig = WGM * nN, gid = wgid / nig, fm = gid * WGM, gsz = (nM - fm) < WGM ? (nM - fm) : WGM;
        u.pm = fm + ((wgid % nig) % gsz); u.pn = (wgid % nig) / gsz; return true;
    }
    __device__ __forceinline__ void a_ready(const Unit&) const {}
    __device__ __forceinline__ void done(const Unit&) const {}
};

__device__ __forceinline__ unsigned cvt_pk_bf16(float lo, float hi) { unsigned r; asm volatile("v_cvt_pk_bf16_f32 %0, %1, %2" : "=v"(r) : "v"(lo), "v"(hi)); return r; }
template <class Epi, class Sched, bool ALIGN_EPI = false, bool SP2 = false>
__device__ __forceinline__ void gemm_phase(PG8_LAS unsigned char* lds, const Gemm g, const Sched& S, const Epi& E) {
    const int tid = threadIdx.x, wid = __builtin_amdgcn_readfirstlane(tid >> 6), lane = tid & 63, wr = wid >> 2, wc = wid & 3, fr = lane & 15, fq = lane >> 4;
    const int K = g.K, nt = K / BK;
    unsigned voffA[2], voffB[2];
#pragma unroll
    for (int i = 0; i < 2; ++i) { int R, C; stage_rc(tid * 16 + i * 8192, R, C); const int Rb = Epi::PERM ? ((R & ~31) + perm32(R & 31)) : R;
        voffA[i] = (unsigned)(R * K + C) * 2u; voffB[i] = (unsigned)(Rb * K + C) * 2u; }
    const size_t kstep = (size_t)(BK * 2);
    const size_t hstep = (size_t)HALF * K * 2;
    const size_t tstep = 2 * hstep;
    const unsigned ldsw = (unsigned)wid * 1024u;
    const int aoff = lds_byte(wr * 64 + fr, fq * 8), boff = lds_byte(wc * 32 + fr, fq * 8);
#define PG8_SA(b, h) (((b) * 2 + (h)) * HTB)
#define PG8_SB(b, h) ((4 + (b) * 2 + (h)) * HTB)
#define PG8_STAGE(bufoff, gbase, voff) do { _Pragma("unroll") for (int _i = 0; _i < 2; ++_i) \
        __builtin_amdgcn_global_load_lds((const unsigned*)((const char*)(gbase) + (voff)[_i]), (PG8_LAS unsigned*)(lds + (bufoff) + ldsw + _i * 8192), 16, 0, 0); } while (0)
#define PG8_LDA(dst, b, h) do { _Pragma("unroll") for (int m = 0; m < 4; ++m) _Pragma("unroll") for (int k = 0; k < 2; ++k) dst[m][k] = *(const PG8_LAS bf16x8*)(lds + PG8_SA(b, h) + aoff + m * 2048 + k * 1024); } while (0)
#define PG8_LDB(dst, b, h) do { _Pragma("unroll") for (int n = 0; n < 2; ++n) _Pragma("unroll") for (int k = 0; k < 2; ++k) dst[n][k] = *(const PG8_LAS bf16x8*)(lds + PG8_SB(b, h) + boff + n * 2048 + k * 1024); } while (0)
#define PG8_MMA(ai, bj, At, Bt) do { __builtin_amdgcn_s_setprio(1); _Pragma("unroll") for (int m = 0; m < 4; ++m) _Pragma("unroll") for (int n = 0; n < 2; ++n) _Pragma("unroll") for (int k = 0; k < 2; ++k) \
        acc[ai][bj][m][n] = __builtin_amdgcn_mfma_f32_16x16x32_bf16(Bt[n][k], At[m][k], acc[ai][bj][m][n], 0, 0, 0); __builtin_amdgcn_s_setprio(0); } while (0)
#define PG8_WAIT_V(n) asm volatile("s_waitcnt vmcnt(" #n ")" ::: "memory")
#define PG8_WAIT_L(n) asm volatile("s_waitcnt lgkmcnt(" #n ")" ::: "memory")
#define PG8_BAR __builtin_amdgcn_s_barrier()
#define PG8_SCHED __builtin_amdgcn_sched_barrier(0)
    Unit cur, nxt; int ui = 0;
    if (!S.next(0, cur)) return;
    f32x4 acc[2][2][4][2];
#pragma unroll
    for (int a = 0; a < 2; ++a)
#pragma unroll
        for (int b = 0; b < 2; ++b)
#pragma unroll
            for (int m = 0; m < 4; ++m)
#pragma unroll
                for (int n = 0; n < 2; ++n) acc[a][b][m][n] = (f32x4){0.f, 0.f, 0.f, 0.f};
    bf16x8 At[4][2], B0[2][2], B1[2][2];
    const char* cA = (const char*)g.A + (size_t)cur.pm * tstep; const char* cB = (const char*)g.Bt + (size_t)cur.pn * tstep;
    S.a_ready(cur);
    if constexpr (SP2) {
        PG8_STAGE(PG8_SB(0, 0), cB, voffB); PG8_STAGE(PG8_SB(0, 1), cB + hstep, voffB); PG8_STAGE(PG8_SA(0, 0), cA, voffA); PG8_STAGE(PG8_SA(0, 1), cA + hstep, voffA);
        if (wr == 1) PG8_BAR;
        PG8_WAIT_V(2); PG8_BAR;
        PG8_STAGE(PG8_SB(1, 0), cB + kstep, voffB); PG8_STAGE(PG8_SA(1, 0), cA + kstep, voffA); PG8_STAGE(PG8_SB(1, 1), cB + hstep + kstep, voffB);
        PG8_WAIT_V(6); PG8_BAR;
    } else {
        PG8_STAGE(PG8_SB(0, 0), cB, voffB); PG8_STAGE(PG8_SA(0, 0), cA, voffA); PG8_STAGE(PG8_SB(0, 1), cB + hstep, voffB); PG8_STAGE(PG8_SA(0, 1), cA + hstep, voffA);
        if (wr == 1) PG8_BAR;
        PG8_WAIT_V(4); PG8_BAR;
        PG8_STAGE(PG8_SB(1, 0), cB + kstep, voffB); PG8_STAGE(PG8_SA(1, 0), cA + kstep, voffA); PG8_STAGE(PG8_SB(1, 1), cB + hstep + kstep, voffB);
        PG8_WAIT_V(6); PG8_BAR;
    }
    for (;;) {
        const bool has_next = S.next(ui + 1, nxt);
        const char* nA = has_next ? (const char*)g.A + (size_t)nxt.pm * tstep : cA; const char* nB = has_next ? (const char*)g.Bt + (size_t)nxt.pn * tstep : cB;
        for (int t = 0; t < nt; t += 2) {
            const bool last = (t == nt - 2);
            const char* a1 = cA + (size_t)(t + 1) * kstep;
            const char* a2 = last ? nA : cA + (size_t)(t + 2) * kstep; const char* b2 = last ? nB : cB + (size_t)(t + 2) * kstep;
            const char* a3 = a2 + kstep; const char* b3 = b2 + kstep;
            if (last && has_next) S.a_ready(nxt);
            if constexpr (SP2) {
            PG8_LDB(B0, 0, 0); PG8_LDB(B1, 0, 1); PG8_SCHED; PG8_LDA(At, 0, 0); PG8_STAGE(PG8_SA(1, 1), a1 + hstep, voffA);
            PG8_WAIT_V(8); PG8_WAIT_L(0); PG8_BAR; PG8_MMA(0, 0, At, B0); PG8_MMA(0, 1, At, B1); PG8_BAR; PG8_SCHED;
            PG8_LDA(At, 0, 1); PG8_STAGE(PG8_SB(0, 0), b2, voffB); PG8_STAGE(PG8_SB(0, 1), b2 + hstep, voffB); PG8_STAGE(PG8_SA(0, 0), a2, voffA);
            PG8_WAIT_V(8); PG8_WAIT_L(0); PG8_BAR; PG8_MMA(1, 0, At, B0); PG8_MMA(1, 1, At, B1); PG8_BAR; PG8_SCHED;
            PG8_LDB(B0, 1, 0); PG8_LDB(B1, 1, 1); PG8_SCHED; PG8_LDA(At, 1, 0); PG8_STAGE(PG8_SA(0, 1), a2 + hstep, voffA);
            PG8_WAIT_V(8); PG8_WAIT_L(0); PG8_BAR; PG8_MMA(0, 0, At, B0); PG8_MMA(0, 1, At, B1); PG8_BAR; PG8_SCHED;
            PG8_LDA(At, 1, 1); PG8_STAGE(PG8_SB(1, 0), b3, voffB); PG8_STAGE(PG8_SB(1, 1), b3 + hstep, voffB); PG8_STAGE(PG8_SA(1, 0), a3, voffA);
            PG8_WAIT_V(8); PG8_WAIT_L(0); PG8_BAR; PG8_MMA(1, 0, At, B0); PG8_MMA(1, 1, At, B1); PG8_BAR; PG8_SCHED;
            } else {
            PG8_LDB(B0, 0, 0); PG8_SCHED; PG8_LDA(At, 0, 0); PG8_STAGE(PG8_SA(1, 1), a1 + hstep, voffA);
            PG8_WAIT_L(8); PG8_BAR; PG8_WAIT_L(0); PG8_MMA(0, 0, At, B0); PG8_BAR; PG8_SCHED;
            PG8_LDB(B1, 0, 1); PG8_STAGE(PG8_SB(0, 0), b2, voffB);
            PG8_BAR; PG8_WAIT_L(0); PG8_MMA(0, 1, At, B1); PG8_BAR;
            PG8_LDA(At, 0, 1); PG8_STAGE(PG8_SA(0, 0), a2, voffA);
            PG8_BAR; PG8_WAIT_L(0); PG8_MMA(1, 0, At, B0); PG8_BAR; PG8_SCHED;
            PG8_STAGE(PG8_SB(0, 1), b2 + hstep, voffB);
            PG8_WAIT_V(6); PG8_BAR; PG8_MMA(1, 1, At, B1); PG8_BAR;
            PG8_LDB(B0, 1, 0); PG8_SCHED; PG8_LDA(At, 1, 0); PG8_STAGE(PG8_SA(0, 1), a2 + hstep, voffA);
            PG8_WAIT_L(8); PG8_BAR; PG8_WAIT_L(0); PG8_MMA(0, 0, At, B0); PG8_BAR; PG8_SCHED;
            PG8_LDB(B1, 1, 1); PG8_STAGE(PG8_SB(1, 0), b3, voffB);
            PG8_BAR; PG8_WAIT_L(0); PG8_MMA(0, 1, At, B1); PG8_BAR;
            PG8_LDA(At, 1, 1); PG8_STAGE(PG8_SA(1, 0), a3, voffA);
            PG8_BAR; PG8_WAIT_L(0); PG8_MMA(1, 0, At, B0); PG8_BAR; PG8_SCHED;
            PG8_STAGE(PG8_SB(1, 1), b3 + hstep, voffB);
            PG8_WAIT_V(6); PG8_BAR; PG8_MMA(1, 1, At, B1); PG8_BAR;
            }
        }
        if constexpr (ALIGN_EPI) { if (wr == 0) PG8_BAR; }
        if constexpr (!Epi::AFTER_DRAIN) { E(acc, cur, wr, wc, fr, fq); S.done(cur); }
        if (!has_next) break;
#pragma unroll
        for (int a = 0; a < 2; ++a)
#pragma unroll
            for (int b = 0; b < 2; ++b)
#pragma unroll
                for (int m = 0; m < 4; ++m)
#pragma unroll
                    for (int n = 0; n < 2; ++n) acc[a][b][m][n] = (f32x4){0.f, 0.f, 0.f, 0.f};
        cur = nxt; cA = nA; cB = nB; ++ui;
        if constexpr (ALIGN_EPI) { if (wr == 1) PG8_BAR; }
    }
    PG8_WAIT_V(0);
    if constexpr (!ALIGN_EPI) { if (wr == 0) PG8_BAR; }
    PG8_BAR;
    if constexpr (Epi::AFTER_DRAIN) { E.fused(acc, cur, wr, wc, fr, fq, lds, wid, lane); S.done(cur); }
#undef PG8_SA
#undef PG8_SB
#undef PG8_STAGE
#undef PG8_LDA
#undef PG8_LDB
#undef PG8_MMA
#undef PG8_WAIT_V
#undef PG8_WAIT_L
#undef PG8_BAR
#undef PG8_SCHED
}
}
namespace pg8 {
struct EpiBf16 {
    static constexpr bool PERM = true, AFTER_DRAIN = false;
    bf16_t* O; int ldc; int row0;
    __device__ __forceinline__ void operator()(const f32x4 (&acc)[2][2][4][2], const Unit& u, int wr, int wc, int fr, int fq) const {
        const int rb = row0 + u.pm * BM + wr * 64 + fr; const int col0 = u.pn * BM + wc * 32 + 8 * fq;
#pragma unroll
        for (int ai = 0; ai < 2; ++ai)
#pragma unroll
            for (int m = 0; m < 4; ++m) { bf16_t* rowp = O + (size_t)(rb + ai * HALF + m * 16) * ldc + col0;
#pragma unroll
                for (int bj = 0; bj < 2; ++bj) { const f32x4 v0 = acc[ai][bj][m][0], v1 = acc[ai][bj][m][1];
                    u32x4 w; w.x = cvt_pk_bf16(v0[0], v0[1]); w.y = cvt_pk_bf16(v0[2], v0[3]); w.z = cvt_pk_bf16(v1[0], v1[1]); w.w = cvt_pk_bf16(v1[2], v1[3]);
                    *(u32x4*)(rowp + bj * HALF) = w; } }
    }
};
struct EpiRes {
    static constexpr bool PERM = false, AFTER_DRAIN = false;
    const float* res_ctx; const float* res_lat; const float* gate_ctx; const float* gate_lat; float* R; int row0; float alpha;
    __device__ __forceinline__ void operator()(const f32x4 (&acc)[2][2][4][2], const Unit& u, int wr, int wc, int fr, int fq) const {
        const int rb = row0 + u.pm * BM + wr * 64 + fr; const int colb = u.pn * BM + wc * 32 + 4 * fq;
#pragma unroll
        for (int ai = 0; ai < 2; ++ai)
#pragma unroll
            for (int m = 0; m < 4; ++m) { const int r = rb + ai * HALF + m * 16;
                const float* rs = (r < 256) ? res_ctx + (size_t)r * 2048 : res_lat + (size_t)(r - 256) * 2048;
                const float* gt = (r < 256) ? gate_ctx : gate_lat;
#pragma unroll
                for (int bj = 0; bj < 2; ++bj)
#pragma unroll
                    for (int n = 0; n < 2; ++n) { const int c = colb + bj * HALF + n * 16;
                        const f32x4 xr = *(const f32x4*)(rs + c); const f32x4 g = *(const f32x4*)(gt + c);
                        #ifdef DBG_NO_Y
                        const f32x4 o = xr * alpha;
#else
                        const f32x4 o = xr * alpha + g * acc[ai][bj][m][n];
#endif
                        *(f32x4*)(R + (size_t)r * 2048 + c) = o; } }
    }
};
}
#define WSP(T, off) ((T*)(P->ws + (off)))

__device__ __forceinline__ void transpose_item(const float* __restrict__ W, int N, bf16_t* __restrict__ WT, int k0, int n0, int dst_row0, LAS float* scr, int lane) {
#pragma unroll 8
    for (int i = 0; i < 32; ++i) { const int kk = 2 * i + (lane >> 5); scr[kk * 33 + (lane & 31)] = W[(size_t)(k0 + kk) * N + n0 + (lane & 31)]; }
    LDS_WAIT();
    const int c = lane & 7;
#pragma unroll
    for (int j = 0; j < 4; ++j) { const int n = (lane >> 3) + 8 * j; const LAS float* s = scr + (8 * c) * 33 + n;
        u32x4 o; o.x = pk2(s[0 * 33], s[1 * 33]); o.y = pk2(s[2 * 33], s[3 * 33]); o.z = pk2(s[4 * 33], s[5 * 33]); o.w = pk2(s[6 * 33], s[7 * 33]);
        *(u32x4*)(WT + (size_t)(dst_row0 + n) * 2048 + k0 + 8 * c) = o; }
    LDS_WAIT();
}

__device__ __forceinline__ void convert_flat(const float* __restrict__ src, bf16_t* __restrict__ dst, size_t n8, int gwi, int NGW, int lane) {
    for (size_t i = (size_t)gwi * 64 + lane; i < n8; i += (size_t)NGW * 64) {
        const f32x4 a = __builtin_nontemporal_load((const f32x4*)src + 2 * i), b = __builtin_nontemporal_load((const f32x4*)src + 2 * i + 1);
        u32x4 o; o.x = pk2(a[0], a[1]); o.y = pk2(a[2], a[3]); o.z = pk2(b[0], b[1]); o.w = pk2(b[2], b[3]);
        *((u32x4*)dst + i) = o;
    }
}

__device__ __forceinline__ void phase_prologue(KP P, LAS unsigned char* lds, int tid, int lane, int wave) {
    LAS float* sil = (LAS float*)lds;
    for (int i = tid; i < 4096; i += 512) { const float v = (i < 2048) ? P->c[i] : P->c_ctx[i - 2048]; sil[i] = v / (1.f + __expf(-v)); }
    __syncthreads();
    const int G = gridDim.x, gwi = wave * G + blockIdx.x, NGW = G * 8;
    float* MOD = WSP(float, WS_MOD);
    for (int it = gwi; it < 768; it += NGW) {
        const int l = it / 384, cb = it % 384, col = cb * 32 + (lane & 31), kh = lane >> 5;
        const float* w = P->w_ada + (size_t)l * 2048 * MODW + col;
        float a0 = 0.f, a1 = 0.f;
#pragma unroll 8
        for (int k = kh; k < 2048; k += 2) { const float wv = __builtin_nontemporal_load(w + (size_t)k * MODW); a0 += sil[k] * wv; a1 += sil[2048 + k] * wv; }
        a0 += __shfl_xor(a0, 32); a1 += __shfl_xor(a1, 32);
        if (lane < 32) { const float b = P->b_ada[l * MODW + col]; MOD[(l * 2 + 0) * MODW + col] = a0 + b; MOD[(l * 2 + 1) * MODW + col] = a1 + b; }
    }
    LAS float* scr = (LAS float*)(lds + 16384 + wave * 8704);
    constexpr int IT_IN = 32 * 153, IT_SQ = 32 * 64;
    for (int it = gwi; it < 2 * IT_IN + 4 * IT_SQ; it += NGW) {
        if (it < 2 * IT_IN) { const int l = it / IT_IN, r = it % IT_IN, kb = r / 153, nb = r % 153, n0 = nb * 32;
            const int dst = (n0 < 2560) ? n0 : (n0 < 2592 ? n0 - 2560 + C_DT : n0 - 32);
            transpose_item(P->w_in + (size_t)l * 2048 * IN_W, IN_W, WSP(bf16_t, WS_WIN) + (size_t)l * NPROJ * 2048, kb * 64, n0, dst, scr, lane);
        } else { const int r0 = it - 2 * IT_IN, m = r0 / IT_SQ, r = r0 % IT_SQ, kb = r / 64, nb = r % 64, l = m & 1;
            const float* src = (m < 2 ? P->w_out : P->peer_wq) + (size_t)l * 2048 * 2048;
            bf16_t* dstp = (m < 2 ? WSP(bf16_t, WS_WOUT) : WSP(bf16_t, WS_WQ)) + (size_t)l * 2048 * 2048;
            transpose_item(src, 2048, dstp, kb * 64, nb * 32, nb * 32, scr, lane);
        }
    }
    for (int i = gwi * 64 + lane; i < 2 * 224 * 256; i += NGW * 64) { const int l = i / (224 * 256), r = i % (224 * 256);
        *((u32x4*)(WSP(bf16_t, WS_WIN) + (size_t)l * NPROJ * 2048 + (size_t)IN_W * 2048) + r) = (u32x4){0u, 0u, 0u, 0u}; }
    convert_flat(P->peer_u, WSP(bf16_t, WS_U), (size_t)2 * NEXP * 2048 / 8, gwi, NGW, lane);
    convert_flat(P->peer_v, WSP(bf16_t, WS_V), (size_t)2 * NEXP * 2048 / 8, gwi, NGW, lane);
    for (int i = gwi * 64 + lane; i < 2 * 2 * 16384 / 8; i += NGW * 64) { const int l = i / 4096, r = i % 4096, wh = r / 2048, e = r % 2048;
        const float* src = (wh ? P->k2 : P->k1) + (size_t)l * 16384 + e * 8;
        const f32x4 a = *(const f32x4*)src, b = *(const f32x4*)(src + 4);
        u32x4 o; o.x = pk2(a[0], a[1]); o.y = pk2(a[2], a[3]); o.z = pk2(b[0], b[1]); o.w = pk2(b[2], b[3]);
        *((u32x4*)WSP(bf16_t, WS_PK) + i) = o; }
    if (blockIdx.x == 0) { float* RT = WSP(float, WS_ROPE);
        for (int i = tid; i < 2048; i += 512) { const int pos = i >> 4, f = i & 15; const float inv = powf(10000.0f, -(float)f / 16.0f); const float ang = (float)pos * inv;
            float sn, cs; sincosf(ang, &sn, &cs); RT[i] = cs; RT[2048 + i] = sn; } }
}

__device__ __forceinline__ void modulate_store_bf16(const f32x4 (&v)[8], const float* __restrict__ sh, const float* __restrict__ sc, bf16_t* __restrict__ hrow, int lane) {
#pragma unroll
    for (int j = 0; j < 8; ++j) { const int e = (j * 64 + lane) * 4; const f32x4 s = *(const f32x4*)(sc + e), b = *(const f32x4*)(sh + e);
        const f32x4 o = v[j] * (s + 1.0f) + b; u32x2 w; w.x = pk2(o[0], o[1]); w.y = pk2(o[2], o[3]); *(u32x2*)(hrow + e) = w; }
}
__device__ __forceinline__ void layer_norm_row(f32x4 (&v)[8], const float* __restrict__ g, const float* __restrict__ b, int lane) {
    float s = 0.f;
#pragma unroll
    for (int j = 0; j < 8; ++j) s += (v[j][0] + v[j][1]) + (v[j][2] + v[j][3]);
    const float mu = wave_sum(s) * (1.f / 2048.f); float q = 0.f;
#pragma unroll
    for (int j = 0; j < 8; ++j) { v[j] = v[j] - mu; q += (v[j][0] * v[j][0] + v[j][1] * v[j][1]) + (v[j][2] * v[j][2] + v[j][3] * v[j][3]); }
    const float rstd = rsqrtf(wave_sum(q) * (1.f / 2048.f) + LN_EPS);
#pragma unroll
    for (int j = 0; j < 8; ++j) { const int e = (j * 64 + lane) * 4; v[j] = v[j] * rstd * *(const f32x4*)(g + e) + *(const f32x4*)(b + e); }
}

__device__ __forceinline__ void phase_mod0(KP P, int lane, int wave) {
    const int gw = blockIdx.x * 8 + wave, NGW = gridDim.x * 8;
    const float* MOD = WSP(float, WS_MOD);
    for (int row = gw; row < TOK; row += NGW) {
        const float* xr = (row < 256) ? P->ctx + (size_t)row * 2048 : P->x + (size_t)(row - 256) * 2048;
        const float* md = MOD + (row < 256 ? 1 : 0) * MODW;
        f32x4 v[8];
#pragma unroll
        for (int j = 0; j < 8; ++j) v[j] = *(const f32x4*)(xr + (j * 64 + lane) * 4);
        modulate_store_bf16(v, md + MO_SH1, md + MO_SC1, WSP(bf16_t, WS_H) + (size_t)row * 2048, lane);
    }
}

__device__ __forceinline__ void phase_post(KP P, int l, LAS unsigned char* lds, int tid) {
    bf16_t* PROJ = WSP(bf16_t, WS_PROJ); bf16_t* XBC = WSP(bf16_t, WS_XBC); bf16_t* XBCT = WSP(bf16_t, WS_XBCT); bf16_t* VT = WSP(bf16_t, WS_VT);
    float* DT = WSP(float, WS_DT); const float* RT = WSP(float, WS_ROPE);
    for (int u = blockIdx.x; u < 132 * 8; u += gridDim.x) {
        const int type = u / 132, tile = u % 132, r0 = tile * 64;
        if (type < 6) {
            const int ch0 = type * 256; const int lo = (r0 < 256) ? 0 : 256, hi = (r0 < 256) ? 256 : TOK;
            LAS unsigned char* IN = lds; LAS bf16_t* OUT = (LAS bf16_t*)(lds + 68 * 512);
            for (int idx = tid; idx < 68 * 32; idx += 512) { const int rr = idx >> 5, cc = idx & 31, grow = r0 - 2 + rr;
                u32x4 v = {0u, 0u, 0u, 0u};
                if (grow >= lo && grow < hi) v = *(const u32x4*)(PROJ + (size_t)grow * NPROJ + C_XBC + ch0 + cc * 8);
                *(LAS u32x4*)(IN + rr * 512 + cc * 16) = v; }
            __syncthreads();
            { const int c = tid & 255, half = tid >> 8, ch = ch0 + c;
              const float* cw = P->conv_w + ((size_t)l * 1536 + ch) * 5; const float w0 = cw[0], w1 = cw[1], w2 = cw[2], w3 = cw[3], w4 = cw[4], bb = P->conv_b[l * 1536 + ch];
              const LAS bf16_t* inp = (const LAS bf16_t*)IN + c; const int i0 = half * 32;
              float a0 = bf1(inp[(i0 + 0) * 256]), a1 = bf1(inp[(i0 + 1) * 256]), a2 = bf1(inp[(i0 + 2) * 256]), a3 = bf1(inp[(i0 + 3) * 256]);
              for (int i = i0; i < i0 + 32; ++i) { const float a4 = bf1(inp[(i + 4) * 256]);
                  float v = bb + w0 * a0 + w1 * a1 + w2 * a2 + w3 * a3 + w4 * a4; v = v * sigmoidf_(v);
                  const bf16_t o = f2bf(v); OUT[i * 256 + c] = o; XBC[(size_t)(r0 + i) * 1536 + ch] = o;
                  a0 = a1; a1 = a2; a2 = a3; a3 = a4; } }
            __syncthreads();
            if (type < 5) {
                for (int idx = tid; idx < 2048; idx += 512) { const int chunk = idx & 7, c = idx >> 3;
                    const LAS bf16_t* s = OUT + (chunk * 8) * 256 + c;
                    u32x4 o; o.x = (unsigned)s[0] | ((unsigned)s[256] << 16); o.y = (unsigned)s[512] | ((unsigned)s[768] << 16);
                    o.z = (unsigned)s[1024] | ((unsigned)s[1280] << 16); o.w = (unsigned)s[1536] | ((unsigned)s[1792] << 16);
                    *(u32x4*)(XBCT + (size_t)(ch0 + c) * TOK + r0 + chunk * 8) = o; }
            }
            __syncthreads();
        } else if (type == 6) {
            for (int idx = tid; idx < 2048; idx += 512) { const int rr = idx >> 5, j = idx & 31;
                const float raw = bf1(PROJ[(size_t)(r0 + rr) * NPROJ + C_DT + j]) + P->dt_bias[l * 32 + j];
                DT[(size_t)(r0 + rr) * 32 + j] = (raw > 20.f) ? raw : log1pf(__expf(raw)); }
            if (r0 >= 256) {
                for (int idx = tid; idx < 64 * 320; idx += 512) { const int i = idx & 15, hf = (idx >> 4) & 1, hd = (idx >> 5) % 10, rr = idx / 320;
                    const int t = r0 + rr - 256, pos = hf ? (t & 63) : (t >> 6);
                    const float cs = RT[pos * 16 + i], sn = RT[2048 + pos * 16 + i];
                    bf16_t* p = PROJ + (size_t)(r0 + rr) * NPROJ + (hd < 8 ? C_WQ + hd * 64 : C_WK + (hd - 8) * 64) + hf * 32 + i;
                    const float p1 = bf1(p[0]), p2 = bf1(p[16]);
                    p[0] = f2bf(p1 * cs - p2 * sn); p[16] = f2bf(p1 * sn + p2 * cs); }
            }
        } else {
            LAS unsigned char* T = lds;
            for (int idx = tid; idx < 64 * 80; idx += 512) { const int rr = idx / 80, cc = idx % 80; const int col = cc < 16 ? C_WV + cc * 8 : C_NV + (cc - 16) * 8;
                *(LAS u32x4*)(T + rr * 1280 + cc * 16) = *(const u32x4*)(PROJ + (size_t)(r0 + rr) * NPROJ + col); }
            __syncthreads();
            for (int idx = tid; idx < 640 * 8; idx += 512) { const int chunk = idx & 7, c = idx >> 3;
                const LAS bf16_t* s = (const LAS bf16_t*)T + (chunk * 8) * 640 + c;
                u32x4 o; o.x = (unsigned)s[0] | ((unsigned)s[640] << 16); o.y = (unsigned)s[1280] | ((unsigned)s[1920] << 16);
                o.z = (unsigned)s[2560] | ((unsigned)s[3200] << 16); o.w = (unsigned)s[3840] | ((unsigned)s[4480] << 16);
                *(u32x4*)(VT + (size_t)c * TOK + r0 + chunk * 8) = o; }
            __syncthreads();
        }
    }
}

template <int MODE>
__device__ __forceinline__ void attn_item(KP P, int l, int item, int lane) {
    const bf16_t* __restrict__ PROJ = WSP(bf16_t, WS_PROJ); const bf16_t* __restrict__ VT = WSP(bf16_t, WS_VT); bf16_t* MIX = WSP(bf16_t, WS_MIX);
    const int g = lane >> 4, c16 = lane & 15;
    const int hq = item & 7, qb = item >> 3;
    const bool WINM = (MODE == 0 || MODE == 2);
    const int q0 = qb * 16;
    const int qrow0 = (MODE <= 1) ? 256 + q0 : q0;
    const int qcol = WINM ? C_WQ + hq * 64 : C_NQ + hq * 64;
    const int kcol = WINM ? C_WK + (hq >> 2) * 64 : C_NK + hq * 64;
    const int vrow = WINM ? (hq >> 2) * 64 : 128 + hq * 64;
    const int ocol = WINM ? 1024 + hq * 64 : 1536 + hq * 64;
    bf16x8 qf[2];
#pragma unroll
    for (int dk = 0; dk < 2; ++dk) qf[dk] = *(const bf16x8*)(PROJ + (size_t)(qrow0 + c16) * NPROJ + qcol + dk * 32 + g * 8);
    float m, lsum;
    if (WINM) { m = P->sink[l * 8 + hq] * LOG2E; lsum = (g == 0) ? 1.f : 0.f; } else { m = -1e30f; lsum = 0.f; }
    f32x4 o[4];
#pragma unroll
    for (int dt = 0; dt < 4; ++dt) o[dt] = (f32x4){0.f, 0.f, 0.f, 0.f};
    int nloc = 0, kstart = 0, rs = 0, cw = 0, r = 0, cq = 0;
    if (MODE == 0) { kstart = (q0 - 128 > 0 ? q0 - 128 : 0) & ~31; const int kend = (q0 + 144 < SEQ) ? q0 + 144 : SEQ; nloc = (kend - kstart + 31) >> 5; }
    if (MODE == 1) { r = q0 >> 6; const int cb16 = q0 & 63; rs = r - 4; rs = rs < 0 ? 0 : (rs > 120 ? 120 : rs); cw = cb16 - 8; cw = cw < 0 ? 0 : (cw > 32 ? 32 : cw); nloc = 8; cq = cb16 + c16; }
    const int ntile = nloc + 8;
    const float* rpb = P->rpb + ((size_t)l * 8 + hq) * 15 * 31;
    for (int t = 0; t < ntile; ++t) {
        int kb = 0, krow;
        if (t < nloc) { kb = (MODE == 0) ? kstart + 32 * t : (rs + t) * 64 + cw; krow = 256 + kb; } else krow = (t - nloc) * 32;
        bf16x8 kf[2][2]; s16x4 vf[4][2];
#pragma unroll
        for (int kt = 0; kt < 2; ++kt)
#pragma unroll
            for (int dk = 0; dk < 2; ++dk) kf[kt][dk] = *(const bf16x8*)(PROJ + (size_t)(krow + 16 * kt + c16) * NPROJ + kcol + dk * 32 + g * 8);
#pragma unroll
        for (int dt = 0; dt < 4; ++dt)
#pragma unroll
            for (int kt = 0; kt < 2; ++kt) vf[dt][kt] = *(const s16x4*)(VT + (size_t)(vrow + 16 * dt + c16) * TOK + krow + 16 * kt + 4 * g);
        f32x4 s[2];
#pragma unroll
        for (int kt = 0; kt < 2; ++kt) { s[kt] = __builtin_amdgcn_mfma_f32_16x16x32_bf16(kf[kt][0], qf[0], (f32x4){0.f, 0.f, 0.f, 0.f}, 0, 0, 0);
            s[kt] = __builtin_amdgcn_mfma_f32_16x16x32_bf16(kf[kt][1], qf[1], s[kt], 0, 0, 0); }
#pragma unroll
        for (int kt = 0; kt < 2; ++kt)
#pragma unroll
            for (int j = 0; j < 4; ++j) { float v = s[kt][j] * QK_SCALE;
                if (t < nloc) {
                    if (MODE == 0) { const int key = kb + 16 * kt + 4 * g + j, q = q0 + c16, d = key - q; if (d > 128 || d < -128) v = -1e30f; }
                    if (MODE == 1) { const int kc = cw + 16 * kt + 4 * g + j; int cs = cq - 8; cs = cs < 0 ? 0 : (cs > 48 ? 48 : cs);
                        if (kc >= cs && kc < cs + 16) v += rpb[((rs + t) - r + 7) * 31 + (kc - cq + 15)] * LOG2E; else v = -1e30f; }
                }
                s[kt][j] = v; }
        float mx = fmaxf(fmaxf(fmaxf(s[0][0], s[0][1]), fmaxf(s[0][2], s[0][3])), fmaxf(fmaxf(s[1][0], s[1][1]), fmaxf(s[1][2], s[1][3])));
        mx = fmaxf(mx, __shfl_xor(mx, 16)); mx = fmaxf(mx, __shfl_xor(mx, 32));
        const float mn = fmaxf(m, mx), al = fexp2(m - mn); m = mn;
        float ps = 0.f;
#pragma unroll
        for (int kt = 0; kt < 2; ++kt)
#pragma unroll
            for (int j = 0; j < 4; ++j) { const float p = fexp2(s[kt][j] - mn); s[kt][j] = p; ps += p; }
        lsum = lsum * al + ps;
        u32x4 pw; pw.x = pk2(s[0][0], s[0][1]); pw.y = pk2(s[0][2], s[0][3]); pw.z = pk2(s[1][0], s[1][1]); pw.w = pk2(s[1][2], s[1][3]);
        const bf16x8 pf = __builtin_bit_cast(bf16x8, pw);
#pragma unroll
        for (int dt = 0; dt < 4; ++dt) { o[dt] = o[dt] * al;
            const bf16x8 va = (bf16x8){vf[dt][0][0], vf[dt][0][1], vf[dt][0][2], vf[dt][0][3], vf[dt][1][0], vf[dt][1][1], vf[dt][1][2], vf[dt][1][3]};
            o[dt] = __builtin_amdgcn_mfma_f32_16x16x32_bf16(va, pf, o[dt], 0, 0, 0); }
    }
    lsum += __shfl_xor(lsum, 16); lsum += __shfl_xor(lsum, 32);
    const float inv = 1.f / lsum;
#pragma unroll
    for (int dt = 0; dt < 4; ++dt) { u32x2 w; w.x = pk2(o[dt][0] * inv, o[dt][1] * inv); w.y = pk2(o[dt][2] * inv, o[dt][3] * inv);
        *(u32x2*)(MIX + (size_t)(qrow0 + c16) * 2048 + ocol + 16 * dt + 4 * g) = w; }
}

__device__ __forceinline__ void ssd_states_unit(KP P, int l, int u, LAS unsigned char* lds, int tid, int lane, int wave) {
    const int cgi = u >> 4, h = u & 15, rowbase = cgi * 128, grp = h >> 3;
    const float* DT = WSP(float, WS_DT); float* ACS = WSP(float, WS_ACS); float* CDEC = WSP(float, WS_CDEC); float* ST = WSP(float, WS_STATES);
    const bf16_t* __restrict__ XBCT = WSP(bf16_t, WS_XBCT);
    LAS float* WF = (LAS float*)lds;
    if (wave < 2) {
        const int d = wave; const float a = -__expf(P->a_log[(l * 2 + d) * 16 + h]);
        const float dt0 = DT[(size_t)(rowbase + 2 * lane) * 32 + d * 16 + h], dt1 = DT[(size_t)(rowbase + 2 * lane + 1) * 32 + d * 16 + h];
        const float e0 = dt0 * a, e1 = dt1 * a;
        float s = e0 + e1;
#pragma unroll
        for (int o = 1; o < 64; o <<= 1) { const float t = __shfl_up(s, o); if (lane >= o) s += t; }
        const float tot = __shfl(s, 63);
        float c0, c1;
        if (d == 0) { c0 = s - e1; c1 = s; } else { c0 = tot - (s - e1 - e0); c1 = tot - (s - e1); }
        ACS[((size_t)d * TOK + rowbase + 2 * lane) * 16 + h] = c0; ACS[((size_t)d * TOK + rowbase + 2 * lane + 1) * 16 + h] = c1;
        WF[d * 128 + 2 * lane] = dt0 * __expf(tot - c0); WF[d * 128 + 2 * lane + 1] = dt1 * __expf(tot - c1);
        if (lane == 0) CDEC[(d * NCH + cgi) * 16 + h] = __expf(tot);
    }
    __syncthreads();
    {
        const int d = wave >> 2, pt = wave & 3, g = lane >> 4, c16 = lane & 15;
        bf16x8 xa[4];
#pragma unroll
        for (int ks = 0; ks < 4; ++ks) { const u32x4 raw = *(const u32x4*)(XBCT + (size_t)(h * 64 + pt * 16 + c16) * TOK + rowbase + ks * 32 + g * 8);
            const LAS float* w = WF + d * 128 + ks * 32 + g * 8;
            u32x4 sc; sc.x = pk2(bflo(raw.x) * w[0], bfhi(raw.x) * w[1]); sc.y = pk2(bflo(raw.y) * w[2], bfhi(raw.y) * w[3]);
            sc.z = pk2(bflo(raw.z) * w[4], bfhi(raw.z) * w[5]); sc.w = pk2(bflo(raw.w) * w[6], bfhi(raw.w) * w[7]);
            xa[ks] = __builtin_bit_cast(bf16x8, sc); }
        float* dst = ST + (((size_t)d * NCH + cgi) * 16 + h) * 8192;
#pragma unroll 2
        for (int nt = 0; nt < 8; ++nt) { f32x4 acc = {0.f, 0.f, 0.f, 0.f};
#pragma unroll
            for (int ks = 0; ks < 4; ++ks) { const bf16x8 bfr = *(const bf16x8*)(XBCT + (size_t)(1024 + grp * 128 + nt * 16 + c16) * TOK + rowbase + ks * 32 + g * 8);
                acc = __builtin_amdgcn_mfma_f32_16x16x32_bf16(xa[ks], bfr, acc, 0, 0, 0); }
#pragma unroll
            for (int j = 0; j < 4; ++j) dst[(pt * 16 + 4 * g + j) * 128 + nt * 16 + c16] = acc[j]; }
    }
    __syncthreads();
}

__device__ __forceinline__ void phase_scan(KP P, int tid) {
    const float* __restrict__ ST = WSP(float, WS_STATES); float* __restrict__ HP = WSP(float, WS_HPREV); const float* __restrict__ CDEC = WSP(float, WS_CDEC);
    for (int e = blockIdx.x * 512 + tid; e < 2 * 16 * 8192; e += gridDim.x * 512) {
        const int d = e >> 17, h = (e >> 13) & 15, pn = e & 8191;
        float hs = 0.f;
#pragma unroll 6
        for (int s = 0; s < NCH; ++s) {
            const int cgi = (d == 0) ? s : (s < 2 ? 1 - s : NCH + 1 - s);
            const size_t idx = (((size_t)d * NCH + cgi) * 16 + h) * 8192 + pn;
            const float st = ST[idx]; HP[idx] = hs; hs = CDEC[(d * NCH + cgi) * 16 + h] * hs + st;
        }
    }
}

__device__ __forceinline__ void ssd_y_unit(KP P, int l, int u, LAS unsigned char* lds, int tid, int lane, int wave) {
    const int cgi = u >> 4, h = u & 15, rowbase = cgi * 128, grp = h >> 3;
    const float* DT = WSP(float, WS_DT); const float* ACS = WSP(float, WS_ACS); const float* __restrict__ HP = WSP(float, WS_HPREV);
    const bf16_t* __restrict__ XBC = WSP(bf16_t, WS_XBC); const bf16_t* __restrict__ XBCT = WSP(bf16_t, WS_XBCT); const bf16_t* __restrict__ PROJ = WSP(bf16_t, WS_PROJ);
    bf16_t* YG = WSP(bf16_t, WS_YG); float* SSQ = WSP(float, WS_SSQ);
    LAS float* AC = (LAS float*)lds;
    LAS float* DTL = AC + 256;
    if (tid < 256) { const int d = tid >> 7, i = tid & 127; AC[tid] = ACS[((size_t)d * TOK + rowbase + i) * 16 + h]; DTL[tid] = DT[(size_t)(rowbase + i) * 32 + d * 16 + h]; }
    __syncthreads();
    const int g = lane >> 4, c16 = lane & 15, w = wave, irow = 16 * w + c16;
    bf16x8 cf[4];
#pragma unroll
    for (int ks = 0; ks < 4; ++ks) cf[ks] = *(const bf16x8*)(XBC + (size_t)(rowbase + irow) * 1536 + 1280 + grp * 128 + ks * 32 + g * 8);
    f32x4 gt[8];
#pragma unroll
    for (int st = 0; st < 8; ++st) { f32x4 acc = {0.f, 0.f, 0.f, 0.f};
#pragma unroll
        for (int ks = 0; ks < 4; ++ks) { const bf16x8 bfr = *(const bf16x8*)(XBC + (size_t)(rowbase + st * 16 + c16) * 1536 + 1024 + grp * 128 + ks * 32 + g * 8);
            acc = __builtin_amdgcn_mfma_f32_16x16x32_bf16(bfr, cf[ks], acc, 0, 0, 0); }
        gt[st] = acc; }
    f32x4 yT[4];
#pragma unroll
    for (int pt = 0; pt < 4; ++pt) yT[pt] = (f32x4){0.f, 0.f, 0.f, 0.f};
#pragma unroll
    for (int d = 0; d < 2; ++d) {
        const float ai = AC[d * 128 + irow];
#pragma unroll
        for (int kp = 0; kp < 4; ++kp) {
            const bool skip = (d == 0) ? (2 * kp > w) : (2 * kp + 1 < w);
            if (!skip) {
                float mv[2][4];
#pragma unroll
                for (int kt = 0; kt < 2; ++kt)
#pragma unroll
                    for (int j = 0; j < 4; ++j) { const int s = (2 * kp + kt) * 16 + 4 * g + j;
                        const bool ok = (d == 0) ? (s <= irow) : (s >= irow);
                        const float dl = fminf(ai - AC[d * 128 + s], 0.f);
                        mv[kt][j] = ok ? gt[2 * kp + kt][j] * __expf(dl) * DTL[d * 128 + s] : 0.f; }
                u32x4 mw; mw.x = pk2(mv[0][0], mv[0][1]); mw.y = pk2(mv[0][2], mv[0][3]); mw.z = pk2(mv[1][0], mv[1][1]); mw.w = pk2(mv[1][2], mv[1][3]);
                const bf16x8 mf = __builtin_bit_cast(bf16x8, mw);
#pragma unroll
                for (int pt = 0; pt < 4; ++pt) { const bf16_t* xp = XBCT + (size_t)(h * 64 + pt * 16 + c16) * TOK + rowbase + kp * 32 + 4 * g;
                    const s16x4 x0 = *(const s16x4*)xp, x1 = *(const s16x4*)(xp + 16);
                    const bf16x8 xa = (bf16x8){x0[0], x0[1], x0[2], x0[3], x1[0], x1[1], x1[2], x1[3]};
                    yT[pt] = __builtin_amdgcn_mfma_f32_16x16x32_bf16(xa, mf, yT[pt], 0, 0, 0); }
            }
        }
        const float ei = __expf(ai);
        const float* hp = HP + (((size_t)d * NCH + cgi) * 16 + h) * 8192;
#pragma unroll
        for (int ks = 0; ks < 4; ++ks) {
            const u32x4 craw = __builtin_bit_cast(u32x4, cf[ks]);
            u32x4 cs; cs.x = pk2(bflo(craw.x) * ei, bfhi(craw.x) * ei); cs.y = pk2(bflo(craw.y) * ei, bfhi(craw.y) * ei);
            cs.z = pk2(bflo(craw.z) * ei, bfhi(craw.z) * ei); cs.w = pk2(bflo(craw.w) * ei, bfhi(craw.w) * ei);
            const bf16x8 cfr = __builtin_bit_cast(bf16x8, cs);
#pragma unroll
            for (int pt = 0; pt < 4; ++pt) { const float* hq = hp + (pt * 16 + c16) * 128 + ks * 32 + g * 8;
                const f32x4 h0 = *(const f32x4*)hq, h1 = *(const f32x4*)(hq + 4);
                u32x4 hw; hw.x = pk2(h0[0], h0[1]); hw.y = pk2(h0[2], h0[3]); hw.z = pk2(h1[0], h1[1]); hw.w = pk2(h1[2], h1[3]);
                yT[pt] = __builtin_amdgcn_mfma_f32_16x16x32_bf16(__builtin_bit_cast(bf16x8, hw), cfr, yT[pt], 0, 0, 0); }
        }
    }
    const int row = rowbase + irow; const float dsk = P->ssd_d[l * 16 + h];
    float ssq = 0.f;
#pragma unroll
    for (int pt = 0; pt < 4; ++pt) { const int col = h * 64 + pt * 16 + 4 * g;
        const u32x2 xr = *(const u32x2*)(XBC + (size_t)row * 1536 + col); const u32x2 zr = *(const u32x2*)(PROJ + (size_t)row * NPROJ + C_Z + col);
        const float xv[4] = {bflo(xr.x), bfhi(xr.x), bflo(xr.y), bfhi(xr.y)}; const float zv[4] = {bflo(zr.x), bfhi(zr.x), bflo(zr.y), bfhi(zr.y)};
        float gv[4];
#pragma unroll
        for (int j = 0; j < 4; ++j) { const float yv = yT[pt][j] + dsk * xv[j]; gv[j] = yv * zv[j] * sigmoidf_(zv[j]); ssq += gv[j] * gv[j]; }
        u32x2 ow; ow.x = pk2(gv[0], gv[1]); ow.y = pk2(gv[2], gv[3]);
        *(u32x2*)(YG + (size_t)row * 1024 + col) = ow; }
    ssq += __shfl_xor(ssq, 16); ssq += __shfl_xor(ssq, 32);
    if (g == 0) SSQ[(size_t)row * 16 + h] = ssq;
    __syncthreads();
}

__device__ __forceinline__ void phase_ssd_finish(KP P, int l, int first_row, int lane, int wave) {
    const int gw = blockIdx.x * 8 + wave, NGW = gridDim.x * 8;
    const bf16_t* YG = WSP(bf16_t, WS_YG); const float* SSQ = WSP(float, WS_SSQ); bf16_t* MIX = WSP(bf16_t, WS_MIX);
    for (int row = first_row + gw; row < TOK; row += NGW) {
        float s = (lane < 16) ? SSQ[(size_t)row * 16 + lane] : 0.f; s = wave_sum(s);
        const float rstd = rsqrtf(s * (1.f / 1024.f) + LN_EPS);
#pragma unroll
        for (int j = 0; j < 2; ++j) { const int e = (j * 64 + lane) * 8; const u32x4 y = *(const u32x4*)(YG + (size_t)row * 1024 + e);
            const f32x4 w0 = *(const f32x4*)(P->norm_w + l * 1024 + e), w1 = *(const f32x4*)(P->norm_w + l * 1024 + e + 4);
            u32x4 o; o.x = pk2(bflo(y.x) * rstd * w0[0], bfhi(y.x) * rstd * w0[1]); o.y = pk2(bflo(y.y) * rstd * w0[2], bfhi(y.y) * rstd * w0[3]);
            o.z = pk2(bflo(y.z) * rstd * w1[0], bfhi(y.z) * rstd * w1[1]); o.w = pk2(bflo(y.w) * rstd * w1[2], bfhi(y.w) * rstd * w1[3]);
            *(u32x4*)(MIX + (size_t)row * 2048 + e) = o; }
    }
}

__device__ __forceinline__ void phase_ln1(KP P, int l, int first_row, int lane, int wave) {
    const int gw = blockIdx.x * 8 + wave, NGW = gridDim.x * 8;
    const float* R = WSP(float, WS_R); float* X = WSP(float, WS_X); const float* MOD = WSP(float, WS_MOD);
    for (int row = first_row + gw; row < TOK; row += NGW) {
        f32x4 v[8];
#pragma unroll
        for (int j = 0; j < 8; ++j) v[j] = *(const f32x4*)(R + (size_t)row * 2048 + (j * 64 + lane) * 4);
        layer_norm_row(v, P->ln1_g + l * 2048, P->ln1_b + l * 2048, lane);
#pragma unroll
        for (int j = 0; j < 8; ++j) *(f32x4*)(X + (size_t)row * 2048 + (j * 64 + lane) * 4) = v[j];
        const float* md = MOD + (l * 2 + (row < 256 ? 1 : 0)) * MODW;
        modulate_store_bf16(v, md + MO_SH2, md + MO_SC2, WSP(bf16_t, WS_H) + (size_t)row * 2048, lane);
    }
}
constexpr int SC_PITCH = 132;
constexpr int ROUTE_WAVE_BYTES = 32 * SC_PITCH * 4;
__device__ __forceinline__ float mkkey(float v, unsigned idx, unsigned mask) { return __uint_as_float((__float_as_uint(v) & ~mask) | idx); }
__device__ __forceinline__ void ins16(float (&top)[16], float v) {
#pragma unroll
    for (int j = 0; j < 16; ++j) { const float hi = fmaxf(top[j], v); v = fminf(top[j], v); top[j] = hi; }
}
__device__ __forceinline__ void route_item(KP P, int l, int item, int first_row, LAS unsigned char* wlds, int lane) {
    const bf16_t* __restrict__ Q = WSP(bf16_t, WS_Q); const bf16_t* __restrict__ PK = WSP(bf16_t, WS_PK) + (size_t)l * 2 * 16384;
    int* EIDX = WSP(int, WS_EIDX); float* GATE = WSP(float, WS_GATE);
    const int hd = item & 7, tb = item >> 3, row0 = first_row + tb * 16;
    const int g = lane >> 4, c16 = lane & 15;
    LAS float* SC = (LAS float*)wlds;
#pragma unroll
    for (int hf = 0; hf < 2; ++hf) {
        bf16x8 qf[4];
#pragma unroll
        for (int ks = 0; ks < 4; ++ks) qf[ks] = *(const bf16x8*)(Q + (size_t)(row0 + c16) * 2048 + hd * 256 + hf * 128 + ks * 32 + g * 8);
#pragma unroll 2
        for (int nt = 0; nt < 8; ++nt) { f32x4 acc = {0.f, 0.f, 0.f, 0.f};
#pragma unroll
            for (int ks = 0; ks < 4; ++ks) { const bf16x8 kf = *(const bf16x8*)(PK + (size_t)hf * 16384 + (nt * 16 + c16) * 128 + ks * 32 + g * 8);
                acc = __builtin_amdgcn_mfma_f32_16x16x32_bf16(kf, qf[ks], acc, 0, 0, 0); }
            *(LAS f32x4*)(SC + (hf * 16 + c16) * SC_PITCH + nt * 16 + 4 * g) = acc; }
    }
    LDS_WAIT();
    float top[16];
    if (lane < 32) {
#pragma unroll
        for (int j = 0; j < 16; ++j) top[j] = -3.0e38f;
        const LAS float* srow = SC + lane * SC_PITCH;
        for (int k = 0; k < 128; k += 4) { const f32x4 v = *(const LAS f32x4*)(srow + k);
            ins16(top, mkkey(v[0], k, 127u)); ins16(top, mkkey(v[1], k + 1, 127u)); ins16(top, mkkey(v[2], k + 2, 127u)); ins16(top, mkkey(v[3], k + 3, 127u)); }
    }
    LDS_WAIT();
    LAS float* TL = SC;
    if (lane < 32) {
#pragma unroll
        for (int j = 0; j < 16; j += 4) *(LAS f32x4*)(TL + lane * 16 + j) = (f32x4){top[j], top[j + 1], top[j + 2], top[j + 3]};
    }
    LDS_WAIT();
    if (lane < 16) {
        float v1[16], v2[16];
#pragma unroll
        for (int j = 0; j < 16; j += 4) { const f32x4 a = *(const LAS f32x4*)(TL + lane * 16 + j), b = *(const LAS f32x4*)(TL + (16 + lane) * 16 + j);
            v1[j] = a[0]; v1[j + 1] = a[1]; v1[j + 2] = a[2]; v1[j + 3] = a[3]; v2[j] = b[0]; v2[j + 1] = b[1]; v2[j + 2] = b[2]; v2[j + 3] = b[3]; }
#pragma unroll
        for (int j = 0; j < 16; ++j) { v1[j] = __uint_as_float(__float_as_uint(v1[j]) & ~127u); v2[j] = __uint_as_float(__float_as_uint(v2[j]) & ~127u); }
        float ct[16];
#pragma unroll
        for (int j = 0; j < 16; ++j) ct[j] = -3.0e38f;
#pragma unroll
        for (int a = 0; a < 16; ++a)
#pragma unroll
            for (int b = 0; b < 16; ++b) if ((a + 1) * (b + 1) <= 16) ins16(ct, mkkey(v1[a] + v2[b], (unsigned)(a * 16 + b), 255u));
        float sv[16]; int ei[16]; float mx = -3.0e38f;
#pragma unroll
        for (int k = 0; k < 16; ++k) { const unsigned code = __float_as_uint(ct[k]) & 255u, a = code >> 4, b = code & 15u;
            const unsigned ka = __float_as_uint(TL[lane * 16 + a]), kb = __float_as_uint(TL[(16 + lane) * 16 + b]);
            sv[k] = __uint_as_float(ka & ~127u) + __uint_as_float(kb & ~127u); ei[k] = (int)((ka & 127u) * 128u + (kb & 127u)); mx = fmaxf(mx, sv[k]); }
        float sum = 0.f;
#pragma unroll
        for (int k = 0; k < 16; ++k) { sv[k] = __expf(sv[k] - mx); sum += sv[k]; }
        const float inv = 1.f / sum; const size_t ob = (size_t)(row0 + lane) * 128 + hd * 16;
#pragma unroll
        for (int k = 0; k < 16; k += 4) { *(int4*)(EIDX + ob + k) = make_int4(ei[k], ei[k + 1], ei[k + 2], ei[k + 3]);
            *(f32x4*)(GATE + ob + k) = (f32x4){sv[k] * inv, sv[k + 1] * inv, sv[k + 2] * inv, sv[k + 3] * inv}; }
    }
    LDS_WAIT();
}


constexpr size_t WS_DBG_SC = 884 * MiB;
constexpr size_t WS_DBG_F = 956 * MiB;
__device__ __forceinline__ void route_naive(KP P, int l, int first_row, int tid) {
    const bf16_t* Q = WSP(bf16_t, WS_Q); const bf16_t* PK = WSP(bf16_t, WS_PK) + (size_t)l * 2 * 16384; float* SCR = WSP(float, WS_DBG_SC);
    int* EIDX = WSP(int, WS_EIDX); float* GATE = WSP(float, WS_GATE);
    for (int idx = blockIdx.x * 512 + tid; idx < (TOK - first_row) * 8; idx += gridDim.x * 512) {
        const int row = first_row + (idx >> 3), hd = idx & 7; float* sc = SCR + (size_t)idx * 256;
        for (int hf = 0; hf < 2; ++hf) for (int n = 0; n < 128; ++n) { float a = 0.f;
            for (int d = 0; d < 128; ++d) a += bf1(Q[(size_t)row * 2048 + hd * 256 + hf * 128 + d]) * bf1(PK[hf * 16384 + n * 128 + d]);
            sc[hf * 128 + n] = a; }
        float v1[16], v2[16]; int i1[16], i2[16];
        for (int k = 0; k < 16; ++k) { float b1 = -3e38f, b2 = -3e38f; int j1 = 0, j2 = 0;
            for (int n = 0; n < 128; ++n) { const float a = sc[n], b = sc[128 + n]; if (a > b1) { b1 = a; j1 = n; } if (b > b2) { b2 = b; j2 = n; } }
            v1[k] = b1; i1[k] = j1; v2[k] = b2; i2[k] = j2; sc[j1] = -3e38f; sc[128 + j2] = -3e38f; }
        for (int a = 0; a < 16; ++a) for (int b = 0; b < 16; ++b) sc[a * 16 + b] = v1[a] + v2[b];
        float ts[16]; int te[16];
        for (int k = 0; k < 16; ++k) { float bb = -3e38f; int jj = 0; for (int n = 0; n < 256; ++n) { const float a = sc[n]; if (a > bb) { bb = a; jj = n; } }
            ts[k] = bb; te[k] = i1[jj >> 4] * 128 + i2[jj & 15]; sc[jj] = -3e38f; }
        float sum = 0.f; for (int k = 0; k < 16; ++k) { ts[k] = __expf(ts[k] - ts[0]); sum += ts[k]; }
        for (int k = 0; k < 16; ++k) { EIDX[(size_t)row * 128 + hd * 16 + k] = te[k]; GATE[(size_t)row * 128 + hd * 16 + k] = ts[k] / sum; }
    }
}
__device__ __forceinline__ void experts_naive_a(KP P, int l, int first_row, int tid) {
    const bf16_t* U = WSP(bf16_t, WS_U) + (size_t)l * NEXP * 2048; const bf16_t* H = WSP(bf16_t, WS_H); const int* EIDX = WSP(int, WS_EIDX); float* GATE = WSP(float, WS_GATE);
    for (int idx = blockIdx.x * 512 + tid; idx < (TOK - first_row) * 128; idx += gridDim.x * 512) {
        const int row = first_row + (idx >> 7), k = idx & 127; const int e = EIDX[(size_t)row * 128 + k]; float a = 0.f;
        for (int d = 0; d < 2048; ++d) a += bf1(U[(size_t)e * 2048 + d]) * bf1(H[(size_t)row * 2048 + d]);
        GATE[(size_t)row * 128 + k] *= 0.5f * a * (1.f + erff(a * 0.70710678118654752f)); }
}
__device__ __forceinline__ void experts_naive_b(KP P, int l, int first_row, int tid) {
    const bf16_t* V = WSP(bf16_t, WS_V) + (size_t)l * NEXP * 2048; const int* EIDX = WSP(int, WS_EIDX); const float* GATE = WSP(float, WS_GATE); float* F = WSP(float, WS_DBG_F);
    for (size_t idx = (size_t)blockIdx.x * 512 + tid; idx < (size_t)(TOK - first_row) * 2048; idx += (size_t)gridDim.x * 512) {
        const int row = first_row + (int)(idx >> 11), d = (int)(idx & 2047); float a = 0.f;
        for (int k = 0; k < 128; ++k) a += GATE[(size_t)row * 128 + k] * bf1(V[(size_t)EIDX[(size_t)row * 128 + k] * 2048 + d]);
        F[(size_t)row * 2048 + d] = a; }
}

__device__ __forceinline__ float dot8(u32x4 av, u32x4 bv, float acc) {
    typedef __bf16 b8 __attribute__((ext_vector_type(8)));
    const b8 a = __builtin_bit_cast(b8, av), b = __builtin_bit_cast(b8, bv);
    acc = __builtin_amdgcn_fdot2_f32_bf16(__builtin_shufflevector(a, a, 0, 1), __builtin_shufflevector(b, b, 0, 1), acc, false);
    acc = __builtin_amdgcn_fdot2_f32_bf16(__builtin_shufflevector(a, a, 2, 3), __builtin_shufflevector(b, b, 2, 3), acc, false);
    acc = __builtin_amdgcn_fdot2_f32_bf16(__builtin_shufflevector(a, a, 4, 5), __builtin_shufflevector(b, b, 4, 5), acc, false);
    acc = __builtin_amdgcn_fdot2_f32_bf16(__builtin_shufflevector(a, a, 6, 7), __builtin_shufflevector(b, b, 6, 7), acc, false);
    return acc;
}
__device__ __forceinline__ void phase_experts(KP P, int l, int first_row, int lane, int wave) {
    const int gw = wave * gridDim.x + blockIdx.x, NGW = gridDim.x * 8;
    const bf16_t* __restrict__ U = WSP(bf16_t, WS_U) + (size_t)l * NEXP * 2048; const bf16_t* __restrict__ V = WSP(bf16_t, WS_V) + (size_t)l * NEXP * 2048;
    const int* EIDX = WSP(int, WS_EIDX); const float* GATE = WSP(float, WS_GATE); bf16_t* H = WSP(bf16_t, WS_H); float* X = WSP(float, WS_X); const float* MOD = WSP(float, WS_MOD);
    for (int row = first_row + gw; row < TOK; row += NGW) {
        u32x4 hv[4];
#pragma unroll
        for (int j = 0; j < 4; ++j) hv[j] = *(const u32x4*)(H + (size_t)row * 2048 + (j * 64 + lane) * 8);
        const int eid0 = EIDX[(size_t)row * 128 + lane], eid1 = EIDX[(size_t)row * 128 + 64 + lane];
        const float gt0 = GATE[(size_t)row * 128 + lane], gt1 = GATE[(size_t)row * 128 + 64 + lane];
#ifndef DBG_NAIVE_EXPERTS
        float cf0 = 0.f, cf1 = 0.f;
#pragma unroll 1
        for (int e = 0; e < 128; e += 4) {
            float part[4];
#pragma unroll
            for (int q = 0; q < 4; ++q) { const int ee = __builtin_amdgcn_readlane((e < 64) ? eid0 : eid1, (e + q) & 63);
                const bf16_t* up = U + (size_t)ee * 2048; float a = 0.f;
#pragma unroll
                for (int j = 0; j < 4; ++j) a = dot8(*(const u32x4*)(up + (j * 64 + lane) * 8), hv[j], a);
                part[q] = a; }
            const bool b5 = lane & 32, b4 = lane & 16;
            float s0 = b5 ? part[0] : part[2], s1 = b5 ? part[1] : part[3];
            float k0 = b5 ? part[2] : part[0], k1 = b5 ? part[3] : part[1];
            k0 += __shfl_xor(s0, 32); k1 += __shfl_xor(s1, 32);
            float sd = b4 ? k0 : k1, kp = b4 ? k1 : k0;
            kp += __shfl_xor(sd, 16);
            kp += __shfl_xor(kp, 8); kp += __shfl_xor(kp, 4); kp += __shfl_xor(kp, 2); kp += __shfl_xor(kp, 1);
            const float ge = 0.5f * kp * (1.f + erff(kp * 0.70710678118654752f));
#pragma unroll
            for (int q = 0; q < 4; ++q) { const float gv = __int_as_float(__builtin_amdgcn_readlane(__float_as_int(ge), 16 * q));
                const float gg = __int_as_float(__builtin_amdgcn_readlane(__float_as_int((e < 64) ? gt0 : gt1), (e + q) & 63));
                const float cv = gv * gg; const bool me = (lane == ((e + q) & 63));
                if (e < 64) cf0 = me ? cv : cf0; else cf1 = me ? cv : cf1; }
        }
        float f[32];
#pragma unroll
        for (int i = 0; i < 32; ++i) f[i] = 0.f;
#pragma unroll 1
        for (int e = 0; e < 128; e += 2) {
#pragma unroll
            for (int q = 0; q < 2; ++q) { const int ee = __builtin_amdgcn_readlane((e < 64) ? eid0 : eid1, (e + q) & 63);
                const float cv = __int_as_float(__builtin_amdgcn_readlane(__float_as_int((e < 64) ? cf0 : cf1), (e + q) & 63));
                const bf16_t* vp = V + (size_t)ee * 2048;
#pragma unroll
                for (int j = 0; j < 4; ++j) { const u32x4 vv = *(const u32x4*)(vp + (j * 64 + lane) * 8);
                    f[j * 8 + 0] += cv * bflo(vv.x); f[j * 8 + 1] += cv * bfhi(vv.x); f[j * 8 + 2] += cv * bflo(vv.y); f[j * 8 + 3] += cv * bfhi(vv.y);
                    f[j * 8 + 4] += cv * bflo(vv.z); f[j * 8 + 5] += cv * bfhi(vv.z); f[j * 8 + 6] += cv * bflo(vv.w); f[j * 8 + 7] += cv * bfhi(vv.w); } }
        }
#else
        float f[32];
#pragma unroll
        for (int j = 0; j < 4; ++j)
#pragma unroll
            for (int i = 0; i < 8; ++i) f[j * 8 + i] = WSP(float, WS_DBG_F)[(size_t)row * 2048 + (j * 64 + lane) * 8 + i];
#endif
        const float* md = MOD + (l * 2 + (row < 256 ? 1 : 0)) * MODW;
        float rv[32]; float s = 0.f;
#pragma unroll
        for (int j = 0; j < 4; ++j) { const int eb = (j * 64 + lane) * 8;
#pragma unroll
            for (int hh = 0; hh < 2; ++hh) { const f32x4 xv = *(const f32x4*)(X + (size_t)row * 2048 + eb + hh * 4), gv = *(const f32x4*)(md + MO_G2 + eb + hh * 4);
#pragma unroll
                for (int i = 0; i < 4; ++i) {
#ifdef DBG_NO_F
                const float r = ALPHA * xv[i];
#else
                const float r = ALPHA * xv[i] + gv[i] * f[j * 8 + hh * 4 + i];
#endif
 rv[j * 8 + hh * 4 + i] = r; s += r; } } }
        const float mu = wave_sum(s) * (1.f / 2048.f); float qq = 0.f;
#pragma unroll
        for (int i = 0; i < 32; ++i) { rv[i] -= mu; qq += rv[i] * rv[i]; }
        const float rstd = rsqrtf(wave_sum(qq) * (1.f / 2048.f) + LN_EPS);
        const float* mdn = MOD + ((l + 1) * 2 + (row < 256 ? 1 : 0)) * MODW;
#pragma unroll
        for (int j = 0; j < 4; ++j) { const int eb = (j * 64 + lane) * 8;
            float ov[8];
#pragma unroll
            for (int hh = 0; hh < 2; ++hh) { const f32x4 gg = *(const f32x4*)(P->ln2_g + l * 2048 + eb + hh * 4), bb = *(const f32x4*)(P->ln2_b + l * 2048 + eb + hh * 4);
#pragma unroll
                for (int i = 0; i < 4; ++i) ov[hh * 4 + i] = rv[j * 8 + hh * 4 + i] * rstd * gg[i] + bb[i]; }
            if (l == 0) {
                *(f32x4*)(X + (size_t)row * 2048 + eb) = (f32x4){ov[0], ov[1], ov[2], ov[3]}; *(f32x4*)(X + (size_t)row * 2048 + eb + 4) = (f32x4){ov[4], ov[5], ov[6], ov[7]};
                const f32x4 s0 = *(const f32x4*)(mdn + MO_SC1 + eb), s1 = *(const f32x4*)(mdn + MO_SC1 + eb + 4), b0 = *(const f32x4*)(mdn + MO_SH1 + eb), b1 = *(const f32x4*)(mdn + MO_SH1 + eb + 4);
                u32x4 w; w.x = pk2(ov[0] * (1.f + s0[0]) + b0[0], ov[1] * (1.f + s0[1]) + b0[1]); w.y = pk2(ov[2] * (1.f + s0[2]) + b0[2], ov[3] * (1.f + s0[3]) + b0[3]);
                w.z = pk2(ov[4] * (1.f + s1[0]) + b1[0], ov[5] * (1.f + s1[1]) + b1[1]); w.w = pk2(ov[6] * (1.f + s1[2]) + b1[2], ov[7] * (1.f + s1[3]) + b1[3]);
                *(u32x4*)(H + (size_t)row * 2048 + eb) = w;
            } else {
                float* op = P->out + (size_t)(row - 256) * 2048 + eb;
                *(f32x4*)op = (f32x4){ov[0], ov[1], ov[2], ov[3]}; *(f32x4*)(op + 4) = (f32x4){ov[4], ov[5], ov[6], ov[7]};
            }
        }
    }
}

constexpr int NTHREADS = 512;
constexpr int LDS_BYTES = 147456;

__global__ void __launch_bounds__(NTHREADS, 2) fwd_megakernel(Params Pk) {
    extern __shared__ __attribute__((aligned(16))) unsigned char lds_raw[];
    LAS unsigned char* lds = (LAS unsigned char*)lds_raw;
    cg::grid_group grid = cg::this_grid();
    int tid = threadIdx.x, lane = tid & 63, wave = __builtin_amdgcn_readfirstlane(tid >> 6);
    const int G = gridDim.x;
    KP P = (KP)__builtin_amdgcn_kernarg_segment_ptr();

#define PFENCE() do { asm volatile("" : "+s"(P), "+v"(tid) :: "memory"); lane = tid & 63; wave = __builtin_amdgcn_readfirstlane(tid >> 6); } while (0)
    phase_prologue(P, lds, tid, lane, wave);
    grid.sync(); PFENCE();
    phase_mod0(P, lane, wave);
    grid.sync(); PFENCE();

#pragma unroll 1
    for (int l = 0; l < 2; ++l) {
        const int first_row = (l == 0) ? 0 : 256;
        const float* MOD = WSP(float, WS_MOD);
        { pg8::Gemm g{WSP(bf16_t, WS_H), WSP(bf16_t, WS_WIN) + (size_t)l * NPROJ * 2048, TOK, NPROJ, 2048}; pg8::StaticOrder S; S.init(TOK, NPROJ, G, (int)blockIdx.x);
          pg8::EpiBf16 E{WSP(bf16_t, WS_PROJ), NPROJ, 0};
          pg8::gemm_phase<pg8::EpiBf16, pg8::StaticOrder, true, true>(lds, g, S, E); }
        grid.sync(); PFENCE();
        phase_post(P, l, lds, tid);
        grid.sync(); PFENCE();
        for (int u = blockIdx.x; u < NCH * 16; u += G) ssd_states_unit(P, l, u, lds, tid, lane, wave);
        { const int gw = wave * G + blockIdx.x, NGW = G * 8;
          for (int it = gw; it < 4096; it += NGW) attn_item<0>(P, l, it, lane);
          for (int it = gw; it < 4096; it += NGW) attn_item<1>(P, l, it, lane);
          if (l == 0) { for (int it = gw; it < 128; it += NGW) attn_item<2>(P, l, it, lane);
                        for (int it = gw; it < 128; it += NGW) attn_item<3>(P, l, it, lane); } }
        grid.sync(); PFENCE();
        phase_scan(P, tid);
        grid.sync(); PFENCE();
        for (int u = blockIdx.x + (l == 0 ? 0 : 32); u < NCH * 16; u += G) ssd_y_unit(P, l, u, lds, tid, lane, wave);
        grid.sync(); PFENCE();
        phase_ssd_finish(P, l, first_row, lane, wave);
        grid.sync(); PFENCE();
        { const float* rc = (l == 0) ? P->ctx : WSP(float, WS_X); const float* rl = (l == 0) ? P->x : WSP(float, WS_X) + (size_t)256 * 2048;
          pg8::Gemm g{WSP(bf16_t, WS_MIX) + (size_t)first_row * 2048, WSP(bf16_t, WS_WOUT) + (size_t)l * 2048 * 2048, TOK - first_row, 2048, 2048};
          pg8::StaticOrder S; S.init(TOK - first_row, 2048, G, (int)blockIdx.x);
          pg8::EpiRes E{rc, rl, MOD + (l * 2 + 1) * MODW + MO_G1, MOD + (l * 2 + 0) * MODW + MO_G1, WSP(float, WS_R), first_row, ALPHA};
          pg8::gemm_phase<pg8::EpiRes, pg8::StaticOrder, true, true>(lds, g, S, E); }
        grid.sync(); PFENCE();
        phase_ln1(P, l, first_row, lane, wave);
        grid.sync(); PFENCE();
        { pg8::Gemm g{WSP(bf16_t, WS_H) + (size_t)first_row * 2048, WSP(bf16_t, WS_WQ) + (size_t)l * 2048 * 2048, TOK - first_row, 2048, 2048};
          pg8::StaticOrder S; S.init(TOK - first_row, 2048, G, (int)blockIdx.x);
          pg8::EpiBf16 E{WSP(bf16_t, WS_Q), 2048, first_row};
          pg8::gemm_phase<pg8::EpiBf16, pg8::StaticOrder, true, true>(lds, g, S, E); }
        grid.sync(); PFENCE();
        { const int gw = wave * G + blockIdx.x, NGW = G * 8; const int nit = ((TOK - first_row) / 16) * 8;
#ifdef DBG_NAIVE_ROUTE
          (void)gw; (void)NGW; (void)nit; route_naive(P, l, first_row, tid); }
#else
          for (int it = gw; it < nit; it += NGW) route_item(P, l, it, first_row, lds + wave * ROUTE_WAVE_BYTES, lane); }
#endif
        grid.sync(); PFENCE();
#ifdef DBG_NAIVE_EXPERTS
        experts_naive_a(P, l, first_row, tid); grid.sync(); PFENCE(); experts_naive_b(P, l, first_row, tid); grid.sync(); PFENCE();
#endif
        phase_experts(P, l, first_row, lane, wave);
        if (l == 0) { grid.sync(); PFENCE(); }
    }
}

extern "C" void kernel_launch(void* const* d_in, const int* in_sizes, int n_in, void* d_out, int out_size, void* d_ws, size_t ws_size, hipStream_t stream) {
    static int grid_blocks = 0;
    if (grid_blocks == 0) {
        if (n_in != 25 || ws_size < WS_END) { fprintf(stderr, "kernel_launch: unexpected inputs (n_in %d, ws %zu)\n", n_in, ws_size); grid_blocks = -1; return; }
        int dev = 0, cus = 0, per_cu = 0;
        hipGetDevice(&dev); hipDeviceGetAttribute(&cus, hipDeviceAttributeMultiprocessorCount, dev);
        hipFuncSetAttribute((const void*)fwd_megakernel, hipFuncAttributeMaxDynamicSharedMemorySize, LDS_BYTES);
        hipOccupancyMaxActiveBlocksPerMultiprocessor(&per_cu, (const void*)fwd_megakernel, NTHREADS, LDS_BYTES);
        if (per_cu < 1) { fprintf(stderr, "kernel_launch: occupancy query says %d blocks per CU\n", per_cu); per_cu = 1; }
        grid_blocks = cus;
        (void)hipGetLastError();
    }
    if (grid_blocks < 0) return;
    Params p{};
    const float** pp = (const float**)&p;
    for (int i = 0; i < 25; ++i) pp[i] = (const float*)d_in[i];
    p.out = (float*)d_out; p.ws = (unsigned char*)d_ws;
    void* args[] = {&p};
    hipError_t e = hipLaunchCooperativeKernel((const void*)fwd_megakernel, dim3(grid_blocks), dim3(NTHREADS), args, LDS_BYTES, stream);
    if (e != hipSuccess) fprintf(stderr, "cooperative launch failed: %s (grid %d)\n", hipGetErrorString(e), grid_blocks);
}
```

```cpp
#include <hip/hip_runtime.h>
#include <hip/hip_cooperative_groups.h>
#include <cstdint>
#include <cstdio>
namespace cg = cooperative_groups;

#define LAS __attribute__((address_space(3)))
typedef short bf16x8 __attribute__((ext_vector_type(8)));
typedef short s16x4 __attribute__((ext_vector_type(4)));
typedef float f32x4 __attribute__((ext_vector_type(4)));
typedef float f32x2 __attribute__((ext_vector_type(2)));
typedef unsigned u32x4 __attribute__((ext_vector_type(4)));
typedef unsigned u32x2 __attribute__((ext_vector_type(2)));
typedef unsigned short bf16_t;

constexpr int DM = 2048, SEQ = 8192, CTXL = 256, TOK = SEQ + CTXL;
constexpr int NPROJ = 5120;
constexpr int C_Z = 0, C_XBC = 1024, C_WQ = 2560, C_WK = 3072, C_WV = 3200, C_NQ = 3328, C_NK = 3840, C_NV = 4352, C_DT = 4864;
constexpr int IN_W = 4896;
constexpr int MO_SH1 = 0, MO_SC1 = 2048, MO_G1 = 4096, MO_SH2 = 6144, MO_SC2 = 8192, MO_G2 = 10240, MODW = 12288;
constexpr int NCH = 66;
constexpr float LN_EPS = 1e-6f;
constexpr float ALPHA = 1.4142135623730951f;
constexpr float LOG2E = 1.4426950408889634f;
constexpr float QK_SCALE = 0.125f * LOG2E;
constexpr int NEXP = 16384;

constexpr size_t MiB = 1u << 20;
constexpr size_t WS_CTL = 0;
constexpr size_t WS_MOD = 1 * MiB;
constexpr size_t WS_ROPE = 1 * MiB + 512 * 1024;
constexpr size_t WS_WIN = 2 * MiB;
constexpr size_t WS_WOUT = 42 * MiB;
constexpr size_t WS_WQ = 58 * MiB;
constexpr size_t WS_PK = 74 * MiB;
constexpr size_t WS_U = 76 * MiB;
constexpr size_t WS_V = 204 * MiB;
constexpr size_t WS_X = 332 * MiB;
constexpr size_t WS_H = 398 * MiB;
constexpr size_t WS_PROJ = 432 * MiB;
constexpr size_t WS_XBC = 516 * MiB;
constexpr size_t WS_XBCT = 542 * MiB;
constexpr size_t WS_VT = 568 * MiB;
constexpr size_t WS_DT = 580 * MiB;
constexpr size_t WS_ACS = 582 * MiB;
constexpr size_t WS_STATES = 584 * MiB;
constexpr size_t WS_CDEC = 650 * MiB;
constexpr size_t WS_YG = 651 * MiB;
constexpr size_t WS_SSQ = 668 * MiB;
constexpr size_t WS_MIX = 670 * MiB;
constexpr size_t WS_R = 704 * MiB;
constexpr size_t WS_Q = 770 * MiB;
constexpr size_t WS_EIDX = 804 * MiB;
constexpr size_t WS_GATE = 809 * MiB;
constexpr size_t WS_HPREV = 814 * MiB;
constexpr size_t WS_END = 880 * MiB;

struct Params {
    const float *x, *c, *ctx, *c_ctx, *w_ada, *b_ada, *w_in, *conv_w, *conv_b, *dt_bias, *a_log, *ssd_d, *norm_w, *sink, *rpb, *w_out,
                *ln1_g, *ln1_b, *peer_wq, *k1, *k2, *peer_u, *peer_v, *ln2_g, *ln2_b;
    float* out; unsigned char* ws;
};

typedef const __attribute__((address_space(4))) Params* KP;

__device__ __forceinline__ unsigned pk2(float lo, float hi) { typedef __bf16 b2 __attribute__((ext_vector_type(2))); f32x2 v = {lo, hi}; b2 b = __builtin_convertvector(v, b2); return __builtin_bit_cast(unsigned, b); }
__device__ __forceinline__ float bflo(unsigned u) { return __uint_as_float(u << 16); }
__device__ __forceinline__ float bfhi(unsigned u) { return __uint_as_float(u & 0xffff0000u); }
__device__ __forceinline__ float bf1(bf16_t u) { return __uint_as_float(((unsigned)u) << 16); }
__device__ __forceinline__ bf16_t f2bf(float f) { return (bf16_t)(pk2(f, 0.f) & 0xffffu); }
__device__ __forceinline__ float wave_sum(float v) {
#pragma unroll
    for (int o = 32; o >= 1; o >>= 1) v += __shfl_xor(v, o);
    return v;
}
__device__ __forceinline__ float fexp2(float x) { return __builtin_amdgcn_exp2f(x); }
__device__ __forceinline__ float sigmoidf_(float v) { return 1.f / (1.f + __expf(-v)); }
#define LDS_WAIT() asm volatile("s_waitcnt lgkmcnt(0)" ::: "memory")

namespace pg8 {
#define PG8_LAS __attribute__((address_space(3)))
typedef unsigned short bf16_t;
typedef short bf16x8 __attribute__((ext_vector_type(8)));
typedef float f32x4 __attribute__((ext_vector_type(4)));
typedef unsigned u32x4 __attribute__((ext_vector_type(4)));
constexpr int BM = 256, BK = 64, HALF = 128, HTB = HALF * BK * 2  , STAGE_BYTES = 8 * HTB, NXCD = 8, WGM = 8;

__host__ __device__ __forceinline__ int lds_byte(int r, int c) { const int st = (r >> 4) * 2 + (c >> 5), rr = r & 15, cc = c & 31, ob = rr * 64 + cc * 2; return st * 1024 + (ob ^ (((ob >> 9) & 1) << 5)); }
__host__ __device__ __forceinline__ void stage_rc(int b, int& R, int& C) { const int st = b / 1024, sb = b % 1024, swz = sb ^ (((sb >> 9) & 1) << 5); R = (st >> 1) * 16 + swz / 64; C = (st & 1) * 32 + (swz % 64) / 2; }
__host__ __device__ __forceinline__ int perm32(int rho) { const int n = rho >> 4, i = rho & 15; return 8 * (i >> 2) + 4 * n + (i & 3); }

struct Unit { int pm, pn; };
struct Gemm { const bf16_t* A; const bf16_t* Bt; int M, N, K; };

struct StaticOrder {
    int nM, nN, nwg, G, c;
    __host__ __device__ void init(int M, int N, int G_, int c_) { nM = M / BM; nN = N / BM; nwg = nM * nN; G = G_; c = c_; }
    __host__ __device__ bool next(int i, Unit& u) const {
        const long L = (long)i * G + c; if (L >= nwg) return false;
        int wgid = (int)L; { const int q = nwg / NXCD, r = nwg % NXCD, xcd = wgid % NXCD, off = wgid / NXCD; wgid = (xcd < r ? xcd * (q + 1) : r * (q + 1) + (xcd - r) * q) + off; }
        const int nig = WGM * nN, gid = wgid / nig, fm = gid * WGM, gsz = (nM - fm) < WGM ? (nM - fm) : WGM;
        u.pm = fm + ((wgid % nig) % gsz); u.pn = (wgid % nig) / gsz; return true;
    }
    __device__ __forceinline__ void a_ready(const Unit&) const {}
    __device__ __forceinline__ void done(const Unit&) const {}
};

__device__ __forceinline__ unsigned cvt_pk_bf16(float lo, float hi) { unsigned r; asm volatile("v_cvt_pk_bf16_f32 %0, %1, %2" : "=v"(r) : "v"(lo), "v"(hi)); return r; }
template <class Epi, class Sched, bool ALIGN_EPI = false, bool SP2 = false>
__device__ __forceinline__ void gemm_phase(PG8_LAS unsigned char* lds, const Gemm g, const Sched& S, const Epi& E) {
    const int tid = threadIdx.x, wid = __builtin_amdgcn_readfirstlane(tid >> 6), lane = tid & 63, wr = wid >> 2, wc = wid & 3, fr = lane & 15, fq = lane >> 4;
    const int K = g.K, nt = K / BK;
    unsigned voffA[2], voffB[2];
#pragma unroll
    for (int i = 0; i < 2; ++i) { int R, C; stage_rc(tid * 16 + i * 8192, R, C); const int Rb = Epi::PERM ? ((R & ~31) + perm32(R & 31)) : R;
        voffA[i] = (unsigned)(R * K + C) * 2u; voffB[i] = (unsigned)(Rb * K + C) * 2u; }
    const size_t kstep = (size_t)(BK * 2);
    const size_t hstep = (size_t)HALF * K * 2;
    const size_t tstep = 2 * hstep;
    const unsigned ldsw = (unsigned)wid * 1024u;
    const int aoff = lds_byte(wr * 64 + fr, fq * 8), boff = lds_byte(wc * 32 + fr, fq * 8);
#define PG8_SA(b, h) (((b) * 2 + (h)) * HTB)
#define PG8_SB(b, h) ((4 + (b) * 2 + (h)) * HTB)
#define PG8_STAGE(bufoff, gbase, voff) do { _Pragma("unroll") for (int _i = 0; _i < 2; ++_i) \
        __builtin_amdgcn_global_load_lds((const unsigned*)((const char*)(gbase) + (voff)[_i]), (PG8_LAS unsigned*)(lds + (bufoff) + ldsw + _i * 8192), 16, 0, 0); } while (0)
#define PG8_LDA(dst, b, h) do { _Pragma("unroll") for (int m = 0; m < 4; ++m) _Pragma("unroll") for (int k = 0; k < 2; ++k) dst[m][k] = *(const PG8_LAS bf16x8*)(lds + PG8_SA(b, h) + aoff + m * 2048 + k * 1024); } while (0)
#define PG8_LDB(dst, b, h) do { _Pragma("unroll") for (int n = 0; n < 2; ++n) _Pragma("unroll") for (int k = 0; k < 2; ++k) dst[n][k] = *(const PG8_LAS bf16x8*)(lds + PG8_SB(b, h) + boff + n * 2048 + k * 1024); } while (0)
#define PG8_MMA(ai, bj, At, Bt) do { __builtin_amdgcn_s_setprio(1); _Pragma("unroll") for (int m = 0; m < 4; ++m) _Pragma("unroll") for (int n = 0; n < 2; ++n) _Pragma("unroll") for (int k = 0; k < 2; ++k) \
        acc[ai][bj][m][n] = __builtin_amdgcn_mfma_f32_16x16x32_bf16(Bt[n][k], At[m][k], acc[ai][bj][m][n], 0, 0, 0); __builtin_amdgcn_s_setprio(0); } while (0)
#define PG8_WAIT_V(n) asm volatile("s_waitcnt vmcnt(" #n ")" ::: "memory")
#define PG8_WAIT_L(n) asm volatile("s_waitcnt lgkmcnt(" #n ")" ::: "memory")
#define PG8_BAR __builtin_amdgcn_s_barrier()
#define PG8_SCHED __builtin_amdgcn_sched_barrier(0)
    Unit cur, nxt; int ui = 0;
    if (!S.next(0, cur)) return;
    f32x4 acc[2][2][4][2];
#pragma unroll
    for (int a = 0; a < 2; ++a)
#pragma unroll
        for (int b = 0; b < 2; ++b)
#pragma unroll
            for (int m = 0; m < 4; ++m)
#pragma unroll
                for (int n = 0; n < 2; ++n) acc[a][b][m][n] = (f32x4){0.f, 0.f, 0.f, 0.f};
    bf16x8 At[4][2], B0[2][2], B1[2][2];
    const char* cA = (const char*)g.A + (size_t)cur.pm * tstep; const char* cB = (const char*)g.Bt + (size_t)cur.pn * tstep;
    S.a_ready(cur);
    if constexpr (SP2) {
        PG8_STAGE(PG8_SB(0, 0), cB, voffB); PG8_STAGE(PG8_SB(0, 1), cB + hstep, voffB); PG8_STAGE(PG8_SA(0, 0), cA, voffA); PG8_STAGE(PG8_SA(0, 1), cA + hstep, voffA);
        if (wr == 1) PG8_BAR;
        PG8_WAIT_V(2); PG8_BAR;
        PG8_STAGE(PG8_SB(1, 0), cB + kstep, voffB); PG8_STAGE(PG8_SA(1, 0), cA + kstep, voffA); PG8_STAGE(PG8_SB(1, 1), cB + hstep + kstep, voffB);
        PG8_WAIT_V(6); PG8_BAR;
    } else {
        PG8_STAGE(PG8_SB(0, 0), cB, voffB); PG8_STAGE(PG8_SA(0, 0), cA, voffA); PG8_STAGE(PG8_SB(0, 1), cB + hstep, voffB); PG8_STAGE(PG8_SA(0, 1), cA + hstep, voffA);
        if (wr == 1) PG8_BAR;
        PG8_WAIT_V(4); PG8_BAR;
        PG8_STAGE(PG8_SB(1, 0), cB + kstep, voffB); PG8_STAGE(PG8_SA(1, 0), cA + kstep, voffA); PG8_STAGE(PG8_SB(1, 1), cB + hstep + kstep, voffB);
        PG8_WAIT_V(6); PG8_BAR;
    }
    for (;;) {
        const bool has_next = S.next(ui + 1, nxt);
        const char* nA = has_next ? (const char*)g.A + (size_t)nxt.pm * tstep : cA; const char* nB = has_next ? (const char*)g.Bt + (size_t)nxt.pn * tstep : cB;
        for (int t = 0; t < nt; t += 2) {
            const bool last = (t == nt - 2);
            const char* a1 = cA + (size_t)(t + 1) * kstep;
            const char* a2 = last ? nA : cA + (size_t)(t + 2) * kstep; const char* b2 = last ? nB : cB + (size_t)(t + 2) * kstep;
            const char* a3 = a2 + kstep; const char* b3 = b2 + kstep;
            if (last && has_next) S.a_ready(nxt);
            if constexpr (SP2) {
            PG8_LDB(B0, 0, 0); PG8_LDB(B1, 0, 1); PG8_SCHED; PG8_LDA(At, 0, 0); PG8_STAGE(PG8_SA(1, 1), a1 + hstep, voffA);
            PG8_WAIT_V(8); PG8_WAIT_L(0); PG8_BAR; PG8_MMA(0, 0, At, B0); PG8_MMA(0, 1, At, B1); PG8_BAR; PG8_SCHED;
            PG8_LDA(At, 0, 1); PG8_STAGE(PG8_SB(0, 0), b2, voffB); PG8_STAGE(PG8_SB(0, 1), b2 + hstep, voffB); PG8_STAGE(PG8_SA(0, 0), a2, voffA);
            PG8_WAIT_V(8); PG8_WAIT_L(0); PG8_BAR; PG8_MMA(1, 0, At, B0); PG8_MMA(1, 1, At, B1); PG8_BAR; PG8_SCHED;
            PG8_LDB(B0, 1, 0); PG8_LDB(B1, 1, 1); PG8_SCHED; PG8_LDA(At, 1, 0); PG8_STAGE(PG8_SA(0, 1), a2 + hstep, voffA);
            PG8_WAIT_V(8); PG8_WAIT_L(0); PG8_BAR; PG8_MMA(0, 0, At, B0); PG8_MMA(0, 1, At, B1); PG8_BAR; PG8_SCHED;
            PG8_LDA(At, 1, 1); PG8_STAGE(PG8_SB(1, 0), b3, voffB); PG8_STAGE(PG8_SB(1, 1), b3 + hstep, voffB); PG8_STAGE(PG8_SA(1, 0), a3, voffA);
            PG8_WAIT_V(8); PG8_WAIT_L(0); PG8_BAR; PG8_MMA(1, 0, At, B0); PG8_MMA(1, 1, At, B1); PG8_BAR; PG8_SCHED;
            } else {
            PG8_LDB(B0, 0, 0); PG8_SCHED; PG8_LDA(At, 0, 0); PG8_STAGE(PG8_SA(1, 1), a1 + hstep, voffA);
            PG8_WAIT_L(8); PG8_BAR; PG8_WAIT_L(0); PG8_MMA(0, 0, At, B0); PG8_BAR; PG8_SCHED;
            PG8_LDB(B1, 0, 1); PG8_STAGE(PG8_SB(0, 0), b2, voffB);
            PG8_BAR; PG8_WAIT_L(0); PG8_MMA(0, 1, At, B1); PG8_BAR;
            PG8_LDA(At, 0, 1); PG8_STAGE(PG8_SA(0, 0), a2, voffA);
            PG8_BAR; PG8_WAIT_L(0); PG8_MMA(1, 0, At, B0); PG8_BAR; PG8_SCHED;
            PG8_STAGE(PG8_SB(0, 1), b2 + hstep, voffB);
            PG8_WAIT_V(6); PG8_BAR; PG8_MMA(1, 1, At, B1); PG8_BAR;
            PG8_LDB(B0, 1, 0); PG8_SCHED; PG8_LDA(At, 1, 0); PG8_STAGE(PG8_SA(0, 1), a2 + hstep, voffA);
            PG8_WAIT_L(8); PG8_BAR; PG8_WAIT_L(0); PG8_MMA(0, 0, At, B0); PG8_BAR; PG8_SCHED;
            PG8_LDB(B1, 1, 1); PG8_STAGE(PG8_SB(1, 0), b3, voffB);
            PG8_BAR; PG8_WAIT_L(0); PG8_MMA(0, 1, At, B1); PG8_BAR;
            PG8_LDA(At, 1, 1); PG8_STAGE(PG8_SA(1, 0), a3, voffA);
            PG8_BAR; PG8_WAIT_L(0); PG8_MMA(1, 0, At, B0); PG8_BAR; PG8_SCHED;
            PG8_STAGE(PG8_SB(1, 1), b3 + hstep, voffB);
            PG8_WAIT_V(6); PG8_BAR; PG8_MMA(1, 1, At, B1); PG8_BAR;
            }
        }
        if constexpr (ALIGN_EPI) { if (wr == 0) PG8_BAR; }
        if constexpr (!Epi::AFTER_DRAIN) { E(acc, cur, wr, wc, fr, fq); S.done(cur); }
        if (!has_next) break;
#pragma unroll
        for (int a = 0; a < 2; ++a)
#pragma unroll
            for (int b = 0; b < 2; ++b)
#pragma unroll
                for (int m = 0; m < 4; ++m)
#pragma unroll
                    for (int n = 0; n < 2; ++n) acc[a][b][m][n] = (f32x4){0.f, 0.f, 0.f, 0.f};
        cur = nxt; cA = nA; cB = nB; ++ui;
        if constexpr (ALIGN_EPI) { if (wr == 1) PG8_BAR; }
    }
    PG8_WAIT_V(0);
    if constexpr (!ALIGN_EPI) { if (wr == 0) PG8_BAR; }
    PG8_BAR;
    if constexpr (Epi::AFTER_DRAIN) { E.fused(acc, cur, wr, wc, fr, fq, lds, wid, lane); S.done(cur); }
#undef PG8_SA
#undef PG8_SB
#undef PG8_STAGE
#undef PG8_LDA
#undef PG8_LDB
#undef PG8_MMA
#undef PG8_WAIT_V
#undef PG8_WAIT_L
#undef PG8_BAR
#undef PG8_SCHED
}
}
namespace pg8 {
struct EpiBf16 {
    static constexpr bool PERM = true, AFTER_DRAIN = false;
    bf16_t* O; int ldc; int row0;
    __device__ __forceinline__ void operator()(const f32x4 (&acc)[2][2][4][2], const Unit& u, int wr, int wc, int fr, int fq) const {
        const int rb = row0 + u.pm * BM + wr * 64 + fr; const int col0 = u.pn * BM + wc * 32 + 8 * fq;
#pragma unroll
        for (int ai = 0; ai < 2; ++ai)
#pragma unroll
            for (int m = 0; m < 4; ++m) { bf16_t* rowp = O + (size_t)(rb + ai * HALF + m * 16) * ldc + col0;
#pragma unroll
                for (int bj = 0; bj < 2; ++bj) { const f32x4 v0 = acc[ai][bj][m][0], v1 = acc[ai][bj][m][1];
                    u32x4 w; w.x = cvt_pk_bf16(v0[0], v0[1]); w.y = cvt_pk_bf16(v0[2], v0[3]); w.z = cvt_pk_bf16(v1[0], v1[1]); w.w = cvt_pk_bf16(v1[2], v1[3]);
                    *(u32x4*)(rowp + bj * HALF) = w; } }
    }
};
struct EpiRes {
    static constexpr bool PERM = false, AFTER_DRAIN = false;
    const float* res_ctx; const float* res_lat; const float* gate_ctx; const float* gate_lat; float* R; int row0; float alpha;
    __device__ __forceinline__ void operator()(const f32x4 (&acc)[2][2][4][2], const Unit& u, int wr, int wc, int fr, int fq) const {
        const int rb = row0 + u.pm * BM + wr * 64 + fr; const int colb = u.pn * BM + wc * 32 + 4 * fq;
#pragma unroll
        for (int ai = 0; ai < 2; ++ai)
#pragma unroll
            for (int m = 0; m < 4; ++m) { const int r = rb + ai * HALF + m * 16;
                const float* rs = (r < 256) ? res_ctx + (size_t)r * 2048 : res_lat + (size_t)(r - 256) * 2048;
                const float* gt = (r < 256) ? gate_ctx : gate_lat;
#pragma unroll
                for (int bj = 0; bj < 2; ++bj)
#pragma unroll
                    for (int n = 0; n < 2; ++n) { const int c = colb + bj * HALF + n * 16;
                        const f32x4 xr = *(const f32x4*)(rs + c); const f32x4 g = *(const f32x4*)(gt + c);
                        #ifdef DBG_NO_Y
                        const f32x4 o = xr * alpha;
#else
                        const f32x4 o = xr * alpha + g * acc[ai][bj][m][n];
#endif
                        *(f32x4*)(R + (size_t)r * 2048 + c) = o; } }
    }
};
}
#define WSP(T, off) ((T*)(P->ws + (off)))

__device__ __forceinline__ void transpose_item(const float* __restrict__ W, int N, bf16_t* __restrict__ WT, int k0, int n0, int dst_row0, LAS float* scr, int lane) {
#pragma unroll 8
    for (int i = 0; i < 32; ++i) { const int kk = 2 * i + (lane >> 5); scr[kk * 33 + (lane & 31)] = W[(size_t)(k0 + kk) * N + n0 + (lane & 31)]; }
    LDS_WAIT();
    const int c = lane & 7;
#pragma unroll
    for (int j = 0; j < 4; ++j) { const int n = (lane >> 3) + 8 * j; const LAS float* s = scr + (8 * c) * 33 + n;
        u32x4 o; o.x = pk2(s[0 * 33], s[1 * 33]); o.y = pk2(s[2 * 33], s[3 * 33]); o.z = pk2(s[4 * 33], s[5 * 33]); o.w = pk2(s[6 * 33], s[7 * 33]);
        *(u32x4*)(WT + (size_t)(dst_row0 + n) * 2048 + k0 + 8 * c) = o; }
    LDS_WAIT();
}

__device__ __forceinline__ void convert_flat(const float* __restrict__ src, bf16_t* __restrict__ dst, size_t n8, int gwi, int NGW, int lane) {
    for (size_t i = (size_t)gwi * 64 + lane; i < n8; i += (size_t)NGW * 64) {
        const f32x4 a = __builtin_nontemporal_load((const f32x4*)src + 2 * i), b = __builtin_nontemporal_load((const f32x4*)src + 2 * i + 1);
        u32x4 o; o.x = pk2(a[0], a[1]); o.y = pk2(a[2], a[3]); o.z = pk2(b[0], b[1]); o.w = pk2(b[2], b[3]);
        *((u32x4*)dst + i) = o;
    }
}

__device__ __forceinline__ void convert_fp8(const float* __restrict__ src, unsigned char* __restrict__ dst, size_t n16, float scale, int gwi, int NGW, int lane) {
    for (size_t i = (size_t)gwi * 64 + lane; i < n16; i += (size_t)NGW * 64) {
        u32x4 o;
#pragma unroll
        for (int c = 0; c < 4; ++c) { const f32x4 a = __builtin_nontemporal_load((const f32x4*)src + 4 * i + c);
            int w = __builtin_amdgcn_cvt_pk_fp8_f32(a[0] * scale, a[1] * scale, 0, false); w = __builtin_amdgcn_cvt_pk_fp8_f32(a[2] * scale, a[3] * scale, w, true); o[c] = (unsigned)w; }
        *((u32x4*)dst + i) = o;
    }
}

__device__ __forceinline__ void phase_prologue(KP P, LAS unsigned char* lds, int tid, int lane, int wave) {
    LAS float* sil = (LAS float*)lds;
    for (int i = tid; i < 4096; i += 512) { const float v = (i < 2048) ? P->c[i] : P->c_ctx[i - 2048]; sil[i] = v / (1.f + __expf(-v)); }
    __syncthreads();
    const int G = gridDim.x, gwi = wave * G + blockIdx.x, NGW = G * 8;
    float* MOD = WSP(float, WS_MOD);
    for (int it = gwi; it < 768; it += NGW) {
        const int l = it / 384, cb = it % 384, col = cb * 32 + (lane & 31), kh = lane >> 5;
        const float* w = P->w_ada + (size_t)l * 2048 * MODW + col;
        float a0 = 0.f, a1 = 0.f;
#pragma unroll 8
        for (int k = kh; k < 2048; k += 2) { const float wv = __builtin_nontemporal_load(w + (size_t)k * MODW); a0 += sil[k] * wv; a1 += sil[2048 + k] * wv; }
        a0 += __shfl_xor(a0, 32); a1 += __shfl_xor(a1, 32);
        if (lane < 32) { const float b = P->b_ada[l * MODW + col]; MOD[(l * 2 + 0) * MODW + col] = a0 + b; MOD[(l * 2 + 1) * MODW + col] = a1 + b; }
    }
    LAS float* scr = (LAS float*)(lds + 16384 + wave * 8704);
    constexpr int IT_IN = 32 * 153, IT_SQ = 32 * 64;
    for (int it = gwi; it < 2 * IT_IN + 4 * IT_SQ; it += NGW) {
        if (it < 2 * IT_IN) { const int l = it / IT_IN, r = it % IT_IN, kb = r / 153, nb = r % 153, n0 = nb * 32;
            const int dst = (n0 < 2560) ? n0 : (n0 < 2592 ? n0 - 2560 + C_DT : n0 - 32);
            transpose_item(P->w_in + (size_t)l * 2048 * IN_W, IN_W, WSP(bf16_t, WS_WIN) + (size_t)l * NPROJ * 2048, kb * 64, n0, dst, scr, lane);
        } else { const int r0 = it - 2 * IT_IN, m = r0 / IT_SQ, r = r0 % IT_SQ, kb = r / 64, nb = r % 64, l = m & 1;
            const float* src = (m < 2 ? P->w_out : P->peer_wq) + (size_t)l * 2048 * 2048;
            bf16_t* dstp = (m < 2 ? WSP(bf16_t, WS_WOUT) : WSP(bf16_t, WS_WQ)) + (size_t)l * 2048 * 2048;
            transpose_item(src, 2048, dstp, kb * 64, nb * 32, nb * 32, scr, lane);
        }
    }
    for (int i = gwi * 64 + lane; i < 2 * 224 * 256; i += NGW * 64) { const int l = i / (224 * 256), r = i % (224 * 256);
        *((u32x4*)(WSP(bf16_t, WS_WIN) + (size_t)l * NPROJ * 2048 + (size_t)IN_W * 2048) + r) = (u32x4){0u, 0u, 0u, 0u}; }
    convert_fp8(P->peer_u, P->ws + WS_U, (size_t)2 * NEXP * 2048 / 16, 1024.f, gwi, NGW, lane);
    convert_fp8(P->peer_v, P->ws + WS_V, (size_t)2 * NEXP * 2048 / 16, 32.f, gwi, NGW, lane);
    for (int i = gwi * 64 + lane; i < 2 * 2 * 16384 / 8; i += NGW * 64) { const int l = i / 4096, r = i % 4096, wh = r / 2048, e = r % 2048;
        const float* src = (wh ? P->k2 : P->k1) + (size_t)l * 16384 + e * 8;
        const f32x4 a = *(const f32x4*)src, b = *(const f32x4*)(src + 4);
        u32x4 o; o.x = pk2(a[0], a[1]); o.y = pk2(a[2], a[3]); o.z = pk2(b[0], b[1]); o.w = pk2(b[2], b[3]);
        *((u32x4*)WSP(bf16_t, WS_PK) + i) = o; }
    if (blockIdx.x == 0) { float* RT = WSP(float, WS_ROPE);
        for (int i = tid; i < 2048; i += 512) { const int pos = i >> 4, f = i & 15; const float inv = powf(10000.0f, -(float)f / 16.0f); const float ang = (float)pos * inv;
            float sn, cs; sincosf(ang, &sn, &cs); RT[i] = cs; RT[2048 + i] = sn; } }
}

__device__ __forceinline__ void modulate_store_bf16(const f32x4 (&v)[8], const float* __restrict__ sh, const float* __restrict__ sc, bf16_t* __restrict__ hrow, int lane) {
#pragma unroll
    for (int j = 0; j < 8; ++j) { const int e = (j * 64 + lane) * 4; const f32x4 s = *(const f32x4*)(sc + e), b = *(const f32x4*)(sh + e);
        const f32x4 o = v[j] * (s + 1.0f) + b; u32x2 w; w.x = pk2(o[0], o[1]); w.y = pk2(o[2], o[3]); *(u32x2*)(hrow + e) = w; }
}
__device__ __forceinline__ void layer_norm_row(f32x4 (&v)[8], const float* __restrict__ g, const float* __restrict__ b, int lane) {
    float s = 0.f;
#pragma unroll
    for (int j = 0; j < 8; ++j) s += (v[j][0] + v[j][1]) + (v[j][2] + v[j][3]);
    const float mu = wave_sum(s) * (1.f / 2048.f); float q = 0.f;
#pragma unroll
    for (int j = 0; j < 8; ++j) { v[j] = v[j] - mu; q += (v[j][0] * v[j][0] + v[j][1] * v[j][1]) + (v[j][2] * v[j][2] + v[j][3] * v[j][3]); }
    const float rstd = rsqrtf(wave_sum(q) * (1.f / 2048.f) + LN_EPS);
#pragma unroll
    for (int j = 0; j < 8; ++j) { const int e = (j * 64 + lane) * 4; v[j] = v[j] * rstd * *(const f32x4*)(g + e) + *(const f32x4*)(b + e); }
}

__device__ __forceinline__ void phase_mod0(KP P, int lane, int wave) {
    const int gw = blockIdx.x * 8 + wave, NGW = gridDim.x * 8;
    const float* MOD = WSP(float, WS_MOD);
    for (int row = gw; row < TOK; row += NGW) {
        const float* xr = (row < 256) ? P->ctx + (size_t)row * 2048 : P->x + (size_t)(row - 256) * 2048;
        const float* md = MOD + (row < 256 ? 1 : 0) * MODW;
        f32x4 v[8];
#pragma unroll
        for (int j = 0; j < 8; ++j) v[j] = *(const f32x4*)(xr + (j * 64 + lane) * 4);
        modulate_store_bf16(v, md + MO_SH1, md + MO_SC1, WSP(bf16_t, WS_H) + (size_t)row * 2048, lane);
    }
}

__device__ __forceinline__ void phase_post(KP P, int l, LAS unsigned char* lds, int tid) {
    bf16_t* PROJ = WSP(bf16_t, WS_PROJ); bf16_t* XBC = WSP(bf16_t, WS_XBC); bf16_t* XBCT = WSP(bf16_t, WS_XBCT); bf16_t* VT = WSP(bf16_t, WS_VT);
    float* DT = WSP(float, WS_DT); const float* RT = WSP(float, WS_ROPE);
    for (int u = blockIdx.x; u < 132 * 8; u += gridDim.x) {
        const int type = u / 132, tile = u % 132, r0 = tile * 64;
        if (type < 6) {
            const int ch0 = type * 256; const int lo = (r0 < 256) ? 0 : 256, hi = (r0 < 256) ? 256 : TOK;
            LAS unsigned char* IN = lds; LAS bf16_t* OUT = (LAS bf16_t*)(lds + 68 * 512);
            for (int idx = tid; idx < 68 * 32; idx += 512) { const int rr = idx >> 5, cc = idx & 31, grow = r0 - 2 + rr;
                u32x4 v = {0u, 0u, 0u, 0u};
                if (grow >= lo && grow < hi) v = *(const u32x4*)(PROJ + (size_t)grow * NPROJ + C_XBC + ch0 + cc * 8);
                *(LAS u32x4*)(IN + rr * 512 + cc * 16) = v; }
            __syncthreads();
            { const int c = tid & 255, half = tid >> 8, ch = ch0 + c;
              const float* cw = P->conv_w + ((size_t)l * 1536 + ch) * 5; const float w0 = cw[0], w1 = cw[1], w2 = cw[2], w3 = cw[3], w4 = cw[4], bb = P->conv_b[l * 1536 + ch];
              const LAS bf16_t* inp = (const LAS bf16_t*)IN + c; const int i0 = half * 32;
              float a0 = bf1(inp[(i0 + 0) * 256]), a1 = bf1(inp[(i0 + 1) * 256]), a2 = bf1(inp[(i0 + 2) * 256]), a3 = bf1(inp[(i0 + 3) * 256]);
              for (int i = i0; i < i0 + 32; ++i) { const float a4 = bf1(inp[(i + 4) * 256]);
                  float v = bb + w0 * a0 + w1 * a1 + w2 * a2 + w3 * a3 + w4 * a4; v = v * sigmoidf_(v);
                  const bf16_t o = f2bf(v); OUT[i * 256 + c] = o; XBC[(size_t)(r0 + i) * 1536 + ch] = o;
                  a0 = a1; a1 = a2; a2 = a3; a3 = a4; } }
            __syncthreads();
            if (type < 5) {
                for (int idx = tid; idx < 2048; idx += 512) { const int chunk = idx & 7, c = idx >> 3;
                    const LAS bf16_t* s = OUT + (chunk * 8) * 256 + c;
                    u32x4 o; o.x = (unsigned)s[0] | ((unsigned)s[256] << 16); o.y = (unsigned)s[512] | ((unsigned)s[768] << 16);
                    o.z = (unsigned)s[1024] | ((unsigned)s[1280] << 16); o.w = (unsigned)s[1536] | ((unsigned)s[1792] << 16);
                    *(u32x4*)(XBCT + (size_t)(ch0 + c) * TOK + r0 + chunk * 8) = o; }
            }
            __syncthreads();
        } else if (type == 6) {
            for (int idx = tid; idx < 2048; idx += 512) { const int rr = idx >> 5, j = idx & 31;
                const float raw = bf1(PROJ[(size_t)(r0 + rr) * NPROJ + C_DT + j]) + P->dt_bias[l * 32 + j];
                DT[(size_t)(r0 + rr) * 32 + j] = (raw > 20.f) ? raw : log1pf(__expf(raw)); }
            if (r0 >= 256) {
                for (int idx = tid; idx < 64 * 320; idx += 512) { const int i = idx & 15, hf = (idx >> 4) & 1, hd = (idx >> 5) % 10, rr = idx / 320;
                    const int t = r0 + rr - 256, pos = hf ? (t & 63) : (t >> 6);
                    const float cs = RT[pos * 16 + i], sn = RT[2048 + pos * 16 + i];
                    bf16_t* p = PROJ + (size_t)(r0 + rr) * NPROJ + (hd < 8 ? C_WQ + hd * 64 : C_WK + (hd - 8) * 64) + hf * 32 + i;
                    const float p1 = bf1(p[0]), p2 = bf1(p[16]);
                    p[0] = f2bf(p1 * cs - p2 * sn); p[16] = f2bf(p1 * sn + p2 * cs); }
            }
        } else {
            LAS unsigned char* T = lds;
            for (int idx = tid; idx < 64 * 80; idx += 512) { const int rr = idx / 80, cc = idx % 80; const int col = cc < 16 ? C_WV + cc * 8 : C_NV + (cc - 16) * 8;
                *(LAS u32x4*)(T + rr * 1280 + cc * 16) = *(const u32x4*)(PROJ + (size_t)(r0 + rr) * NPROJ + col); }
            __syncthreads();
            for (int idx = tid; idx < 640 * 8; idx += 512) { const int chunk = idx & 7, c = idx >> 3;
                const LAS bf16_t* s = (const LAS bf16_t*)T + (chunk * 8) * 640 + c;
                u32x4 o; o.x = (unsigned)s[0] | ((unsigned)s[640] << 16); o.y = (unsigned)s[1280] | ((unsigned)s[1920] << 16);
                o.z = (unsigned)s[2560] | ((unsigned)s[3200] << 16); o.w = (unsigned)s[3840] | ((unsigned)s[4480] << 16);
                *(u32x4*)(VT + (size_t)c * TOK + r0 + chunk * 8) = o; }
            __syncthreads();
        }
    }
}

template <int MODE>
__device__ __forceinline__ void attn_item(KP P, int l, int item, int lane) {
    const bf16_t* __restrict__ PROJ = WSP(bf16_t, WS_PROJ); const bf16_t* __restrict__ VT = WSP(bf16_t, WS_VT); bf16_t* MIX = WSP(bf16_t, WS_MIX);
    const int g = lane >> 4, c16 = lane & 15;
    const int hq = item & 7, qb = item >> 3;
    const bool WINM = (MODE == 0 || MODE == 2);
    const int q0 = qb * 16;
    const int qrow0 = (MODE <= 1) ? 256 + q0 : q0;
    const int qcol = WINM ? C_WQ + hq * 64 : C_NQ + hq * 64;
    const int kcol = WINM ? C_WK + (hq >> 2) * 64 : C_NK + hq * 64;
    const int vrow = WINM ? (hq >> 2) * 64 : 128 + hq * 64;
    const int ocol = WINM ? 1024 + hq * 64 : 1536 + hq * 64;
    bf16x8 qf[2];
#pragma unroll
    for (int dk = 0; dk < 2; ++dk) qf[dk] = *(const bf16x8*)(PROJ + (size_t)(qrow0 + c16) * NPROJ + qcol + dk * 32 + g * 8);
    float m, lsum;
    if (WINM) { m = P->sink[l * 8 + hq] * LOG2E; lsum = (g == 0) ? 1.f : 0.f; } else { m = -1e30f; lsum = 0.f; }
    f32x4 o[4];
#pragma unroll
    for (int dt = 0; dt < 4; ++dt) o[dt] = (f32x4){0.f, 0.f, 0.f, 0.f};
    int nloc = 0, kstart = 0, rs = 0, cw = 0, r = 0, cq = 0;
    if (MODE == 0) { kstart = (q0 - 128 > 0 ? q0 - 128 : 0) & ~31; const int kend = (q0 + 144 < SEQ) ? q0 + 144 : SEQ; nloc = (kend - kstart + 31) >> 5; }
    if (MODE == 1) { r = q0 >> 6; const int cb16 = q0 & 63; rs = r - 4; rs = rs < 0 ? 0 : (rs > 120 ? 120 : rs); cw = cb16 - 8; cw = cw < 0 ? 0 : (cw > 32 ? 32 : cw); nloc = 8; cq = cb16 + c16; }
    const int ntile = nloc + 8;
    const float* rpb = P->rpb + ((size_t)l * 8 + hq) * 15 * 31;
    for (int t = 0; t < ntile; ++t) {
        int kb = 0, krow;
        if (t < nloc) { kb = (MODE == 0) ? kstart + 32 * t : (rs + t) * 64 + cw; krow = 256 + kb; } else krow = (t - nloc) * 32;
        bf16x8 kf[2][2]; s16x4 vf[4][2];
#pragma unroll
        for (int kt = 0; kt < 2; ++kt)
#pragma unroll
            for (int dk = 0; dk < 2; ++dk) kf[kt][dk] = *(const bf16x8*)(PROJ + (size_t)(krow + 16 * kt + c16) * NPROJ + kcol + dk * 32 + g * 8);
#pragma unroll
        for (int dt = 0; dt < 4; ++dt)
#pragma unroll
            for (int kt = 0; kt < 2; ++kt) vf[dt][kt] = *(const s16x4*)(VT + (size_t)(vrow + 16 * dt + c16) * TOK + krow + 16 * kt + 4 * g);
        f32x4 s[2];
#pragma unroll
        for (int kt = 0; kt < 2; ++kt) { s[kt] = __builtin_amdgcn_mfma_f32_16x16x32_bf16(kf[kt][0], qf[0], (f32x4){0.f, 0.f, 0.f, 0.f}, 0, 0, 0);
            s[kt] = __builtin_amdgcn_mfma_f32_16x16x32_bf16(kf[kt][1], qf[1], s[kt], 0, 0, 0); }
#pragma unroll
        for (int kt = 0; kt < 2; ++kt)
#pragma unroll
            for (int j = 0; j < 4; ++j) { float v = s[kt][j] * QK_SCALE;
                if (t < nloc) {
                    if (MODE == 0) { const int key = kb + 16 * kt + 4 * g + j, q = q0 + c16, d = key - q; if (d > 128 || d < -128) v = -1e30f; }
                    if (MODE == 1) { const int kc = cw + 16 * kt + 4 * g + j; int cs = cq - 8; cs = cs < 0 ? 0 : (cs > 48 ? 48 : cs);
                        if (kc >= cs && kc < cs + 16) v += rpb[((rs + t) - r + 7) * 31 + (kc - cq + 15)] * LOG2E; else v = -1e30f; }
                }
                s[kt][j] = v; }
        float mx = fmaxf(fmaxf(fmaxf(s[0][0], s[0][1]), fmaxf(s[0][2], s[0][3])), fmaxf(fmaxf(s[1][0], s[1][1]), fmaxf(s[1][2], s[1][3])));
        mx = fmaxf(mx, __shfl_xor(mx, 16)); mx = fmaxf(mx, __shfl_xor(mx, 32));
        const float mn = fmaxf(m, mx), al = fexp2(m - mn); m = mn;
        float ps = 0.f;
#pragma unroll
        for (int kt = 0; kt < 2; ++kt)
#pragma unroll
            for (int j = 0; j < 4; ++j) { const float p = fexp2(s[kt][j] - mn); s[kt][j] = p; ps += p; }
        lsum = lsum * al + ps;
        u32x4 pw; pw.x = pk2(s[0][0], s[0][1]); pw.y = pk2(s[0][2], s[0][3]); pw.z = pk2(s[1][0], s[1][1]); pw.w = pk2(s[1][2], s[1][3]);
        const bf16x8 pf = __builtin_bit_cast(bf16x8, pw);
#pragma unroll
        for (int dt = 0; dt < 4; ++dt) { o[dt] = o[dt] * al;
            const bf16x8 va = (bf16x8){vf[dt][0][0], vf[dt][0][1], vf[dt][0][2], vf[dt][0][3], vf[dt][1][0], vf[dt][1][1], vf[dt][1][2], vf[dt][1][3]};
            o[dt] = __builtin_amdgcn_mfma_f32_16x16x32_bf16(va, pf, o[dt], 0, 0, 0); }
    }
    lsum += __shfl_xor(lsum, 16); lsum += __shfl_xor(lsum, 32);
    const float inv = 1.f / lsum;
#pragma unroll
    for (int dt = 0; dt < 4; ++dt) { u32x2 w; w.x = pk2(o[dt][0] * inv, o[dt][1] * inv); w.y = pk2(o[dt][2] * inv, o[dt][3] * inv);
        *(u32x2*)(MIX + (size_t)(qrow0 + c16) * 2048 + ocol + 16 * dt + 4 * g) = w; }
}

__device__ __forceinline__ void ssd_states_unit(KP P, int l, int u, LAS unsigned char* lds, int tid, int lane, int wave) {
    const int cgi = u >> 4, h = u & 15, rowbase = cgi * 128, grp = h >> 3;
    const float* DT = WSP(float, WS_DT); float* ACS = WSP(float, WS_ACS); float* CDEC = WSP(float, WS_CDEC); float* ST = WSP(float, WS_STATES);
    const bf16_t* __restrict__ XBCT = WSP(bf16_t, WS_XBCT);
    LAS float* WF = (LAS float*)lds;
    if (wave < 2) {
        const int d = wave; const float a = -__expf(P->a_log[(l * 2 + d) * 16 + h]);
        const float dt0 = DT[(size_t)(rowbase + 2 * lane) * 32 + d * 16 + h], dt1 = DT[(size_t)(rowbase + 2 * lane + 1) * 32 + d * 16 + h];
        const float e0 = dt0 * a, e1 = dt1 * a;
        float s = e0 + e1;
#pragma unroll
        for (int o = 1; o < 64; o <<= 1) { const float t = __shfl_up(s, o); if (lane >= o) s += t; }
        const float tot = __shfl(s, 63);
        float c0, c1;
        if (d == 0) { c0 = s - e1; c1 = s; } else { c0 = tot - (s - e1 - e0); c1 = tot - (s - e1); }
        ACS[((size_t)d * TOK + rowbase + 2 * lane) * 16 + h] = c0; ACS[((size_t)d * TOK + rowbase + 2 * lane + 1) * 16 + h] = c1;
        WF[d * 128 + 2 * lane] = dt0 * __expf(tot - c0); WF[d * 128 + 2 * lane + 1] = dt1 * __expf(tot - c1);
        if (lane == 0) CDEC[(d * NCH + cgi) * 16 + h] = __expf(tot);
    }
    __syncthreads();
    {
        const int d = wave >> 2, pt = wave & 3, g = lane >> 4, c16 = lane & 15;
        bf16x8 xa[4];
#pragma unroll
        for (int ks = 0; ks < 4; ++ks) { const u32x4 raw = *(const u32x4*)(XBCT + (size_t)(h * 64 + pt * 16 + c16) * TOK + rowbase + ks * 32 + g * 8);
            const LAS float* w = WF + d * 128 + ks * 32 + g * 8;
            u32x4 sc; sc.x = pk2(bflo(raw.x) * w[0], bfhi(raw.x) * w[1]); sc.y = pk2(bflo(raw.y) * w[2], bfhi(raw.y) * w[3]);
            sc.z = pk2(bflo(raw.z) * w[4], bfhi(raw.z) * w[5]); sc.w = pk2(bflo(raw.w) * w[6], bfhi(raw.w) * w[7]);
            xa[ks] = __builtin_bit_cast(bf16x8, sc); }
        float* dst = ST + (((size_t)d * NCH + cgi) * 16 + h) * 8192;
#pragma unroll 2
        for (int nt = 0; nt < 8; ++nt) { f32x4 acc = {0.f, 0.f, 0.f, 0.f};
#pragma unroll
            for (int ks = 0; ks < 4; ++ks) { const bf16x8 bfr = *(const bf16x8*)(XBCT + (size_t)(1024 + grp * 128 + nt * 16 + c16) * TOK + rowbase + ks * 32 + g * 8);
                acc = __builtin_amdgcn_mfma_f32_16x16x32_bf16(xa[ks], bfr, acc, 0, 0, 0); }
#pragma unroll
            for (int j = 0; j < 4; ++j) dst[(pt * 16 + 4 * g + j) * 128 + nt * 16 + c16] = acc[j]; }
    }
    __syncthreads();
}

__device__ __forceinline__ void phase_scan(KP P, int tid) {
    const float* __restrict__ ST = WSP(float, WS_STATES); float* __restrict__ HP = WSP(float, WS_HPREV); const float* __restrict__ CDEC = WSP(float, WS_CDEC);
    for (int e = blockIdx.x * 512 + tid; e < 2 * 16 * 8192; e += gridDim.x * 512) {
        const int d = e >> 17, h = (e >> 13) & 15, pn = e & 8191;
        float hs = 0.f;
#pragma unroll 6
        for (int s = 0; s < NCH; ++s) {
            const int cgi = (d == 0) ? s : (s < 2 ? 1 - s : NCH + 1 - s);
            const size_t idx = (((size_t)d * NCH + cgi) * 16 + h) * 8192 + pn;
            const float st = ST[idx]; HP[idx] = hs; hs = CDEC[(d * NCH + cgi) * 16 + h] * hs + st;
        }
    }
}

__device__ __forceinline__ void ssd_y_unit(KP P, int l, int u, LAS unsigned char* lds, int tid, int lane, int wave) {
    const int cgi = u >> 4, h = u & 15, rowbase = cgi * 128, grp = h >> 3;
    const float* DT = WSP(float, WS_DT); const float* ACS = WSP(float, WS_ACS); const float* __restrict__ HP = WSP(float, WS_HPREV);
    const bf16_t* __restrict__ XBC = WSP(bf16_t, WS_XBC); const bf16_t* __restrict__ XBCT = WSP(bf16_t, WS_XBCT); const bf16_t* __restrict__ PROJ = WSP(bf16_t, WS_PROJ);
    bf16_t* YG = WSP(bf16_t, WS_YG); float* SSQ = WSP(float, WS_SSQ);
    LAS float* AC = (LAS float*)lds;
    LAS float* DTL = AC + 256;
    if (tid < 256) { const int d = tid >> 7, i = tid & 127; AC[tid] = ACS[((size_t)d * TOK + rowbase + i) * 16 + h]; DTL[tid] = DT[(size_t)(rowbase + i) * 32 + d * 16 + h]; }
    __syncthreads();
    const int g = lane >> 4, c16 = lane & 15, w = wave, irow = 16 * w + c16;
    bf16x8 cf[4];
#pragma unroll
    for (int ks = 0; ks < 4; ++ks) cf[ks] = *(const bf16x8*)(XBC + (size_t)(rowbase + irow) * 1536 + 1280 + grp * 128 + ks * 32 + g * 8);
    f32x4 gt[8];
#pragma unroll
    for (int st = 0; st < 8; ++st) { f32x4 acc = {0.f, 0.f, 0.f, 0.f};
#pragma unroll
        for (int ks = 0; ks < 4; ++ks) { const bf16x8 bfr = *(const bf16x8*)(XBC + (size_t)(rowbase + st * 16 + c16) * 1536 + 1024 + grp * 128 + ks * 32 + g * 8);
            acc = __builtin_amdgcn_mfma_f32_16x16x32_bf16(bfr, cf[ks], acc, 0, 0, 0); }
        gt[st] = acc; }
    f32x4 yT[4];
#pragma unroll
    for (int pt = 0; pt < 4; ++pt) yT[pt] = (f32x4){0.f, 0.f, 0.f, 0.f};
#pragma unroll
    for (int d = 0; d < 2; ++d) {
        const float ai = AC[d * 128 + irow];
#pragma unroll
        for (int kp = 0; kp < 4; ++kp) {
            const bool skip = (d == 0) ? (2 * kp > w) : (2 * kp + 1 < w);
            if (!skip) {
                float mv[2][4];
#pragma unroll
                for (int kt = 0; kt < 2; ++kt)
#pragma unroll
                    for (int j = 0; j < 4; ++j) { const int s = (2 * kp + kt) * 16 + 4 * g + j;
                        const bool ok = (d == 0) ? (s <= irow) : (s >= irow);
                        const float dl = fminf(ai - AC[d * 128 + s], 0.f);
                        mv[kt][j] = ok ? gt[2 * kp + kt][j] * __expf(dl) * DTL[d * 128 + s] : 0.f; }
                u32x4 mw; mw.x = pk2(mv[0][0], mv[0][1]); mw.y = pk2(mv[0][2], mv[0][3]); mw.z = pk2(mv[1][0], mv[1][1]); mw.w = pk2(mv[1][2], mv[1][3]);
                const bf16x8 mf = __builtin_bit_cast(bf16x8, mw);
#pragma unroll
                for (int pt = 0; pt < 4; ++pt) { const bf16_t* xp = XBCT + (size_t)(h * 64 + pt * 16 + c16) * TOK + rowbase + kp * 32 + 4 * g;
                    const s16x4 x0 = *(const s16x4*)xp, x1 = *(const s16x4*)(xp + 16);
                    const bf16x8 xa = (bf16x8){x0[0], x0[1], x0[2], x0[3], x1[0], x1[1], x1[2], x1[3]};
                    yT[pt] = __builtin_amdgcn_mfma_f32_16x16x32_bf16(xa, mf, yT[pt], 0, 0, 0); }
            }
        }
        const float ei = __expf(ai);
        const float* hp = HP + (((size_t)d * NCH + cgi) * 16 + h) * 8192;
#pragma unroll
        for (int ks = 0; ks < 4; ++ks) {
            const u32x4 craw = __builtin_bit_cast(u32x4, cf[ks]);
            u32x4 cs; cs.x = pk2(bflo(craw.x) * ei, bfhi(craw.x) * ei); cs.y = pk2(bflo(craw.y) * ei, bfhi(craw.y) * ei);
            cs.z = pk2(bflo(craw.z) * ei, bfhi(craw.z) * ei); cs.w = pk2(bflo(craw.w) * ei, bfhi(craw.w) * ei);
            const bf16x8 cfr = __builtin_bit_cast(bf16x8, cs);
#pragma unroll
            for (int pt = 0; pt < 4; ++pt) { const float* hq = hp + (pt * 16 + c16) * 128 + ks * 32 + g * 8;
                const f32x4 h0 = *(const f32x4*)hq, h1 = *(const f32x4*)(hq + 4);
                u32x4 hw; hw.x = pk2(h0[0], h0[1]); hw.y = pk2(h0[2], h0[3]); hw.z = pk2(h1[0], h1[1]); hw.w = pk2(h1[2], h1[3]);
                yT[pt] = __builtin_amdgcn_mfma_f32_16x16x32_bf16(__builtin_bit_cast(bf16x8, hw), cfr, yT[pt], 0, 0, 0); }
        }
    }
    const int row = rowbase + irow; const float dsk = P->ssd_d[l * 16 + h];
    float ssq = 0.f;
#pragma unroll
    for (int pt = 0; pt < 4; ++pt) { const int col = h * 64 + pt * 16 + 4 * g;
        const u32x2 xr = *(const u32x2*)(XBC + (size_t)row * 1536 + col); const u32x2 zr = *(const u32x2*)(PROJ + (size_t)row * NPROJ + C_Z + col);
        const float xv[4] = {bflo(xr.x), bfhi(xr.x), bflo(xr.y), bfhi(xr.y)}; const float zv[4] = {bflo(zr.x), bfhi(zr.x), bflo(zr.y), bfhi(zr.y)};
        float gv[4];
#pragma unroll
        for (int j = 0; j < 4; ++j) { const float yv = yT[pt][j] + dsk * xv[j]; gv[j] = yv * zv[j] * sigmoidf_(zv[j]); ssq += gv[j] * gv[j]; }
        u32x2 ow; ow.x = pk2(gv[0], gv[1]); ow.y = pk2(gv[2], gv[3]);
        *(u32x2*)(YG + (size_t)row * 1024 + col) = ow; }
    ssq += __shfl_xor(ssq, 16); ssq += __shfl_xor(ssq, 32);
    if (g == 0) SSQ[(size_t)row * 16 + h] = ssq;
    __syncthreads();
}

__device__ __forceinline__ void phase_ssd_finish(KP P, int l, int first_row, int lane, int wave) {
    const int gw = blockIdx.x * 8 + wave, NGW = gridDim.x * 8;
    const bf16_t* YG = WSP(bf16_t, WS_YG); const float* SSQ = WSP(float, WS_SSQ); bf16_t* MIX = WSP(bf16_t, WS_MIX);
    for (int row = first_row + gw; row < TOK; row += NGW) {
        float s = (lane < 16) ? SSQ[(size_t)row * 16 + lane] : 0.f; s = wave_sum(s);
        const float rstd = rsqrtf(s * (1.f / 1024.f) + LN_EPS);
#pragma unroll
        for (int j = 0; j < 2; ++j) { const int e = (j * 64 + lane) * 8; const u32x4 y = *(const u32x4*)(YG + (size_t)row * 1024 + e);
            const f32x4 w0 = *(const f32x4*)(P->norm_w + l * 1024 + e), w1 = *(const f32x4*)(P->norm_w + l * 1024 + e + 4);
            u32x4 o; o.x = pk2(bflo(y.x) * rstd * w0[0], bfhi(y.x) * rstd * w0[1]); o.y = pk2(bflo(y.y) * rstd * w0[2], bfhi(y.y) * rstd * w0[3]);
            o.z = pk2(bflo(y.z) * rstd * w1[0], bfhi(y.z) * rstd * w1[1]); o.w = pk2(bflo(y.w) * rstd * w1[2], bfhi(y.w) * rstd * w1[3]);
            *(u32x4*)(MIX + (size_t)row * 2048 + e) = o; }
    }
}

__device__ __forceinline__ void phase_ln1(KP P, int l, int first_row, int lane, int wave) {
    const int gw = blockIdx.x * 8 + wave, NGW = gridDim.x * 8;
    const float* R = WSP(float, WS_R); float* X = WSP(float, WS_X); const float* MOD = WSP(float, WS_MOD);
    for (int row = first_row + gw; row < TOK; row += NGW) {
        f32x4 v[8];
#pragma unroll
        for (int j = 0; j < 8; ++j) v[j] = *(const f32x4*)(R + (size_t)row * 2048 + (j * 64 + lane) * 4);
        layer_norm_row(v, P->ln1_g + l * 2048, P->ln1_b + l * 2048, lane);
#pragma unroll
        for (int j = 0; j < 8; ++j) *(f32x4*)(X + (size_t)row * 2048 + (j * 64 + lane) * 4) = v[j];
        const float* md = MOD + (l * 2 + (row < 256 ? 1 : 0)) * MODW;
        modulate_store_bf16(v, md + MO_SH2, md + MO_SC2, WSP(bf16_t, WS_H) + (size_t)row * 2048, lane);
    }
}
constexpr float U_SCALE = 1024.f, V_SCALE = 32.f;
constexpr int SC_PITCH = 132;
constexpr int ROUTE_WAVE_BYTES = 32 * SC_PITCH * 4;
__device__ __forceinline__ float mkkey(float v, unsigned idx, unsigned mask) { return __uint_as_float((__float_as_uint(v) & ~mask) | idx); }
__device__ __forceinline__ void ins16(float (&top)[16], float v) {
#pragma unroll
    for (int j = 0; j < 16; ++j) { const float hi = fmaxf(top[j], v); v = fminf(top[j], v); top[j] = hi; }
}
__device__ __forceinline__ void route_item(KP P, int l, int item, int first_row, LAS unsigned char* wlds, int lane) {
    const bf16_t* __restrict__ Q = WSP(bf16_t, WS_Q); const bf16_t* __restrict__ PK = WSP(bf16_t, WS_PK) + (size_t)l * 2 * 16384;
    int* EIDX = WSP(int, WS_EIDX); float* GATE = WSP(float, WS_GATE);
    const int hd = item & 7, tb = item >> 3, row0 = first_row + tb * 16;
    const int g = lane >> 4, c16 = lane & 15;
    LAS float* SC = (LAS float*)wlds;
#pragma unroll
    for (int hf = 0; hf < 2; ++hf) {
        bf16x8 qf[4];
#pragma unroll
        for (int ks = 0; ks < 4; ++ks) qf[ks] = *(const bf16x8*)(Q + (size_t)(row0 + c16) * 2048 + hd * 256 + hf * 128 + ks * 32 + g * 8);
#pragma unroll 2
        for (int nt = 0; nt < 8; ++nt) { f32x4 acc = {0.f, 0.f, 0.f, 0.f};
#pragma unroll
            for (int ks = 0; ks < 4; ++ks) { const bf16x8 kf = *(const bf16x8*)(PK + (size_t)hf * 16384 + (nt * 16 + c16) * 128 + ks * 32 + g * 8);
                acc = __builtin_amdgcn_mfma_f32_16x16x32_bf16(kf, qf[ks], acc, 0, 0, 0); }
            *(LAS f32x4*)(SC + (hf * 16 + c16) * SC_PITCH + nt * 16 + 4 * g) = acc; }
    }
    LDS_WAIT();
    float top[16];
    if (lane < 32) {
#pragma unroll
        for (int j = 0; j < 16; ++j) top[j] = -3.0e38f;
        const LAS float* srow = SC + lane * SC_PITCH;
        for (int k = 0; k < 128; k += 4) { const f32x4 v = *(const LAS f32x4*)(srow + k);
            ins16(top, mkkey(v[0], k, 127u)); ins16(top, mkkey(v[1], k + 1, 127u)); ins16(top, mkkey(v[2], k + 2, 127u)); ins16(top, mkkey(v[3], k + 3, 127u)); }
    }
    LDS_WAIT();
    LAS float* TL = SC;
    if (lane < 32) {
#pragma unroll
        for (int j = 0; j < 16; j += 4) *(LAS f32x4*)(TL + lane * 16 + j) = (f32x4){top[j], top[j + 1], top[j + 2], top[j + 3]};
    }
    LDS_WAIT();
    if (lane < 16) {
        float v1[16], v2[16];
#pragma unroll
        for (int j = 0; j < 16; j += 4) { const f32x4 a = *(const LAS f32x4*)(TL + lane * 16 + j), b = *(const LAS f32x4*)(TL + (16 + lane) * 16 + j);
            v1[j] = a[0]; v1[j + 1] = a[1]; v1[j + 2] = a[2]; v1[j + 3] = a[3]; v2[j] = b[0]; v2[j + 1] = b[1]; v2[j + 2] = b[2]; v2[j + 3] = b[3]; }
#pragma unroll
        for (int j = 0; j < 16; ++j) { v1[j] = __uint_as_float(__float_as_uint(v1[j]) & ~127u); v2[j] = __uint_as_float(__float_as_uint(v2[j]) & ~127u); }
        float ct[16];
#pragma unroll
        for (int j = 0; j < 16; ++j) ct[j] = -3.0e38f;
#pragma unroll
        for (int a = 0; a < 16; ++a)
#pragma unroll
            for (int b = 0; b < 16; ++b) if ((a + 1) * (b + 1) <= 16) ins16(ct, mkkey(v1[a] + v2[b], (unsigned)(a * 16 + b), 255u));
        float sv[16]; int ei[16]; float mx = -3.0e38f;
#pragma unroll
        for (int k = 0; k < 16; ++k) { const unsigned code = __float_as_uint(ct[k]) & 255u, a = code >> 4, b = code & 15u;
            const unsigned ka = __float_as_uint(TL[lane * 16 + a]), kb = __float_as_uint(TL[(16 + lane) * 16 + b]);
            sv[k] = __uint_as_float(ka & ~127u) + __uint_as_float(kb & ~127u); ei[k] = (int)((ka & 127u) * 128u + (kb & 127u)); mx = fmaxf(mx, sv[k]); }
        float sum = 0.f;
#pragma unroll
        for (int k = 0; k < 16; ++k) { sv[k] = __expf(sv[k] - mx); sum += sv[k]; }
        const float inv = 1.f / sum; const size_t ob = (size_t)(row0 + lane) * 128 + hd * 16;
#pragma unroll
        for (int k = 0; k < 16; k += 4) { *(int4*)(EIDX + ob + k) = make_int4(ei[k], ei[k + 1], ei[k + 2], ei[k + 3]);
            *(f32x4*)(GATE + ob + k) = (f32x4){sv[k] * inv, sv[k + 1] * inv, sv[k + 2] * inv, sv[k + 3] * inv}; }
    }
    LDS_WAIT();
}


constexpr size_t WS_DBG_SC = 884 * MiB;
constexpr size_t WS_DBG_F = 956 * MiB;
__device__ __forceinline__ void route_naive(KP P, int l, int first_row, int tid) {
    const bf16_t* Q = WSP(bf16_t, WS_Q); const bf16_t* PK = WSP(bf16_t, WS_PK) + (size_t)l * 2 * 16384; float* SCR = WSP(float, WS_DBG_SC);
    int* EIDX = WSP(int, WS_EIDX); float* GATE = WSP(float, WS_GATE);
    for (int idx = blockIdx.x * 512 + tid; idx < (TOK - first_row) * 8; idx += gridDim.x * 512) {
        const int row = first_row + (idx >> 3), hd = idx & 7; float* sc = SCR + (size_t)idx * 256;
        for (int hf = 0; hf < 2; ++hf) for (int n = 0; n < 128; ++n) { float a = 0.f;
            for (int d = 0; d < 128; ++d) a += bf1(Q[(size_t)row * 2048 + hd * 256 + hf * 128 + d]) * bf1(PK[hf * 16384 + n * 128 + d]);
            sc[hf * 128 + n] = a; }
        float v1[16], v2[16]; int i1[16], i2[16];
        for (int k = 0; k < 16; ++k) { float b1 = -3e38f, b2 = -3e38f; int j1 = 0, j2 = 0;
            for (int n = 0; n < 128; ++n) { const float a = sc[n], b = sc[128 + n]; if (a > b1) { b1 = a; j1 = n; } if (b > b2) { b2 = b; j2 = n; } }
            v1[k] = b1; i1[k] = j1; v2[k] = b2; i2[k] = j2; sc[j1] = -3e38f; sc[128 + j2] = -3e38f; }
        for (int a = 0; a < 16; ++a) for (int b = 0; b < 16; ++b) sc[a * 16 + b] = v1[a] + v2[b];
        float ts[16]; int te[16];
        for (int k = 0; k < 16; ++k) { float bb = -3e38f; int jj = 0; for (int n = 0; n < 256; ++n) { const float a = sc[n]; if (a > bb) { bb = a; jj = n; } }
            ts[k] = bb; te[k] = i1[jj >> 4] * 128 + i2[jj & 15]; sc[jj] = -3e38f; }
        float sum = 0.f; for (int k = 0; k < 16; ++k) { ts[k] = __expf(ts[k] - ts[0]); sum += ts[k]; }
        for (int k = 0; k < 16; ++k) { EIDX[(size_t)row * 128 + hd * 16 + k] = te[k]; GATE[(size_t)row * 128 + hd * 16 + k] = ts[k] / sum; }
    }
}
__device__ __forceinline__ void experts_naive_a(KP P, int l, int first_row, int tid) {
    const unsigned char* U = P->ws + WS_U + (size_t)l * NEXP * 2048; const bf16_t* H = WSP(bf16_t, WS_H); const int* EIDX = WSP(int, WS_EIDX); float* GATE = WSP(float, WS_GATE);
    for (int idx = blockIdx.x * 512 + tid; idx < (TOK - first_row) * 128; idx += gridDim.x * 512) {
        const int row = first_row + (idx >> 7), k = idx & 127; const int e = EIDX[(size_t)row * 128 + k]; float a = 0.f;
        for (int d = 0; d < 2048; d += 2) { const f32x2 u2 = __builtin_amdgcn_cvt_pk_f32_fp8((int)*(const unsigned short*)(U + (size_t)e * 2048 + d), false); a += u2.x * bf1(H[(size_t)row * 2048 + d]) + u2.y * bf1(H[(size_t)row * 2048 + d + 1]); }
        a *= (1.f / U_SCALE);
        GATE[(size_t)row * 128 + k] *= 0.5f * a * (1.f + erff(a * 0.70710678118654752f)); }
}
__device__ __forceinline__ void experts_naive_b(KP P, int l, int first_row, int tid) {
    const unsigned char* V = P->ws + WS_V + (size_t)l * NEXP * 2048; const int* EIDX = WSP(int, WS_EIDX); const float* GATE = WSP(float, WS_GATE); float* F = WSP(float, WS_DBG_F);
    for (size_t idx = (size_t)blockIdx.x * 512 + tid; idx < (size_t)(TOK - first_row) * 2048; idx += (size_t)gridDim.x * 512) {
        const int row = first_row + (int)(idx >> 11), d = (int)(idx & 2047); float a = 0.f;
        for (int k = 0; k < 128; ++k) { const unsigned short w2 = *(const unsigned short*)(V + (size_t)EIDX[(size_t)row * 128 + k] * 2048 + (d & ~1)); const f32x2 v2 = __builtin_amdgcn_cvt_pk_f32_fp8((int)w2, false); a += GATE[(size_t)row * 128 + k] * ((d & 1) ? v2.y : v2.x) * (1.f / V_SCALE); }
        F[(size_t)row * 2048 + d] = a; }
}

__device__ __forceinline__ float dot8(u32x4 av, u32x4 bv, float acc) {
    typedef __bf16 b8 __attribute__((ext_vector_type(8)));
    const b8 a = __builtin_bit_cast(b8, av), b = __builtin_bit_cast(b8, bv);
    acc = __builtin_amdgcn_fdot2_f32_bf16(__builtin_shufflevector(a, a, 0, 1), __builtin_shufflevector(b, b, 0, 1), acc, false);
    acc = __builtin_amdgcn_fdot2_f32_bf16(__builtin_shufflevector(a, a, 2, 3), __builtin_shufflevector(b, b, 2, 3), acc, false);
    acc = __builtin_amdgcn_fdot2_f32_bf16(__builtin_shufflevector(a, a, 4, 5), __builtin_shufflevector(b, b, 4, 5), acc, false);
    acc = __builtin_amdgcn_fdot2_f32_bf16(__builtin_shufflevector(a, a, 6, 7), __builtin_shufflevector(b, b, 6, 7), acc, false);
    return acc;
}
#define EX_LOAD(buf, T8, e0) do { _Pragma("unroll") for (int q_ = 0; q_ < 4; ++q_) { \
        const int ee_ = __builtin_amdgcn_readlane(((e0) < 64) ? eid0 : eid1, ((e0) + q_) & 63); \
        const unsigned char* rp_ = (T8) + (size_t)ee_ * 2048 + lane * 16; \
        buf[2 * q_] = __builtin_nontemporal_load((const u32x4*)rp_); buf[2 * q_ + 1] = __builtin_nontemporal_load((const u32x4*)(rp_ + 1024)); } } while (0)
#define EX_DOT(buf, e0) do { float part_[4]; \
        _Pragma("unroll") for (int q_ = 0; q_ < 4; ++q_) { float a0_ = 0.f, a1_ = 0.f; \
            _Pragma("unroll") for (int j_ = 0; j_ < 2; ++j_) _Pragma("unroll") for (int c_ = 0; c_ < 4; ++c_) { \
                const f32x2 lo_ = __builtin_amdgcn_cvt_pk_f32_fp8((int)buf[2 * q_ + j_][c_], false), hi_ = __builtin_amdgcn_cvt_pk_f32_fp8((int)buf[2 * q_ + j_][c_], true); \
                a0_ += lo_.x * hf[j_ * 16 + c_ * 4 + 0]; a1_ += lo_.y * hf[j_ * 16 + c_ * 4 + 1]; a0_ += hi_.x * hf[j_ * 16 + c_ * 4 + 2]; a1_ += hi_.y * hf[j_ * 16 + c_ * 4 + 3]; } \
            part_[q_] = a0_ + a1_; } \
        const bool b5_ = lane & 32, b4_ = lane & 16; \
        const float s0_ = b5_ ? part_[0] : part_[2], s1_ = b5_ ? part_[1] : part_[3]; \
        float k0_ = b5_ ? part_[2] : part_[0], k1_ = b5_ ? part_[3] : part_[1]; \
        k0_ += __shfl_xor(s0_, 32); k1_ += __shfl_xor(s1_, 32); \
        const float sd_ = b4_ ? k0_ : k1_; float kp_ = b4_ ? k1_ : k0_; \
        kp_ += __shfl_xor(sd_, 16); kp_ += __shfl_xor(kp_, 8); kp_ += __shfl_xor(kp_, 4); kp_ += __shfl_xor(kp_, 2); kp_ += __shfl_xor(kp_, 1); \
        kp_ *= (1.f / U_SCALE); \
        const float ge_ = 0.5f * kp_ * (1.f + erff(kp_ * 0.70710678118654752f)); \
        _Pragma("unroll") for (int q_ = 0; q_ < 4; ++q_) { const float gv_ = __int_as_float(__builtin_amdgcn_readlane(__float_as_int(ge_), 16 * q_)); \
            const float gg_ = __int_as_float(__builtin_amdgcn_readlane(__float_as_int(((e0) < 64) ? gt0 : gt1), ((e0) + q_) & 63)); \
            const float cv_ = gv_ * gg_ * (1.f / V_SCALE); const bool me_ = (lane == (((e0) + q_) & 63)); \
            if ((e0) < 64) cf0 = me_ ? cv_ : cf0; else cf1 = me_ ? cv_ : cf1; } } while (0)
#define EX_AXPY(buf, e0) do { _Pragma("unroll") for (int q_ = 0; q_ < 4; ++q_) { \
        const float cv_ = __int_as_float(__builtin_amdgcn_readlane(__float_as_int(((e0) < 64) ? cf0 : cf1), ((e0) + q_) & 63)); \
        _Pragma("unroll") for (int j_ = 0; j_ < 2; ++j_) _Pragma("unroll") for (int c_ = 0; c_ < 4; ++c_) { \
            const f32x2 lo_ = __builtin_amdgcn_cvt_pk_f32_fp8((int)buf[2 * q_ + j_][c_], false), hi_ = __builtin_amdgcn_cvt_pk_f32_fp8((int)buf[2 * q_ + j_][c_], true); \
            f[j_ * 16 + c_ * 4 + 0] += cv_ * lo_.x; f[j_ * 16 + c_ * 4 + 1] += cv_ * lo_.y; f[j_ * 16 + c_ * 4 + 2] += cv_ * hi_.x; f[j_ * 16 + c_ * 4 + 3] += cv_ * hi_.y; } } } while (0)

__device__ __forceinline__ void phase_experts(KP P, int l, int first_row, int lane, int wave) {
    const int gw = wave * gridDim.x + blockIdx.x, NGW = gridDim.x * 8;
    const unsigned char* __restrict__ U8 = P->ws + WS_U + (size_t)l * NEXP * 2048; const unsigned char* __restrict__ V8 = P->ws + WS_V + (size_t)l * NEXP * 2048;
    const int* EIDX = WSP(int, WS_EIDX); const float* GATE = WSP(float, WS_GATE); bf16_t* H = WSP(bf16_t, WS_H); float* X = WSP(float, WS_X); const float* MOD = WSP(float, WS_MOD);
    for (int row = first_row + gw; row < TOK; row += NGW) {
        float hf[32];
#pragma unroll
        for (int j = 0; j < 2; ++j) { const u32x4 h0 = *(const u32x4*)(H + (size_t)row * 2048 + (j * 64 + lane) * 16), h1 = *(const u32x4*)(H + (size_t)row * 2048 + (j * 64 + lane) * 16 + 8);
#pragma unroll
            for (int c = 0; c < 4; ++c) { hf[j * 16 + 2 * c] = bflo(h0[c]); hf[j * 16 + 2 * c + 1] = bfhi(h0[c]); hf[j * 16 + 8 + 2 * c] = bflo(h1[c]); hf[j * 16 + 8 + 2 * c + 1] = bfhi(h1[c]); } }
        const int eid0 = EIDX[(size_t)row * 128 + lane], eid1 = EIDX[(size_t)row * 128 + 64 + lane];
        const float gt0 = GATE[(size_t)row * 128 + lane], gt1 = GATE[(size_t)row * 128 + 64 + lane];
        float f[32];
#ifndef DBG_NAIVE_EXPERTS
        float cf0 = 0.f, cf1 = 0.f;
        u32x4 bA[8], bB[8];
        EX_LOAD(bA, U8, 0);
#pragma unroll 1
        for (int e = 0; e < 128; e += 8) {
            EX_LOAD(bB, U8, e + 4);
            EX_DOT(bA, e);
            if (e + 8 < 128) EX_LOAD(bA, U8, e + 8); else EX_LOAD(bA, V8, 0);
            EX_DOT(bB, e + 4);
        }
#pragma unroll
        for (int i = 0; i < 32; ++i) f[i] = 0.f;
#pragma unroll 1
        for (int e = 0; e < 128; e += 8) {
            EX_LOAD(bB, V8, e + 4);
            EX_AXPY(bA, e);
            if (e + 8 < 128) EX_LOAD(bA, V8, e + 8);
            EX_AXPY(bB, e + 4);
        }
#else
#pragma unroll
        for (int j = 0; j < 2; ++j)
#pragma unroll
            for (int i = 0; i < 16; ++i) f[j * 16 + i] = WSP(float, WS_DBG_F)[(size_t)row * 2048 + (j * 64 + lane) * 16 + i];
#endif
        const float* md = MOD + (l * 2 + (row < 256 ? 1 : 0)) * MODW;
        float s = 0.f;
#pragma unroll
        for (int j = 0; j < 2; ++j) { const int eb = (j * 64 + lane) * 16;
#pragma unroll
            for (int hh = 0; hh < 4; ++hh) { const f32x4 xv = *(const f32x4*)(X + (size_t)row * 2048 + eb + hh * 4), gv = *(const f32x4*)(md + MO_G2 + eb + hh * 4);
#pragma unroll
                for (int i = 0; i < 4; ++i) {
#ifdef DBG_NO_F
                    const float r = ALPHA * xv[i];
#else
                    const float r = ALPHA * xv[i] + gv[i] * f[j * 16 + hh * 4 + i];
#endif
                    f[j * 16 + hh * 4 + i] = r; s += r; }
                asm volatile("" ::: "memory"); } }
        const float mu = wave_sum(s) * (1.f / 2048.f); float qq = 0.f;
#pragma unroll
        for (int i = 0; i < 32; ++i) { f[i] -= mu; qq += f[i] * f[i]; }
        const float rstd = rsqrtf(wave_sum(qq) * (1.f / 2048.f) + LN_EPS);
        const float* mdn = MOD + ((l + 1) * 2 + (row < 256 ? 1 : 0)) * MODW;
#pragma unroll
        for (int j = 0; j < 2; ++j)
#pragma unroll
            for (int hh = 0; hh < 2; ++hh) { const int eb = (j * 64 + lane) * 16 + hh * 8;
                float ov[8];
#pragma unroll
                for (int q = 0; q < 2; ++q) { const f32x4 gg = *(const f32x4*)(P->ln2_g + l * 2048 + eb + q * 4), bb = *(const f32x4*)(P->ln2_b + l * 2048 + eb + q * 4);
#pragma unroll
                    for (int i = 0; i < 4; ++i) ov[q * 4 + i] = f[j * 16 + hh * 8 + q * 4 + i] * rstd * gg[i] + bb[i]; }
                if (l == 0) {
                    *(f32x4*)(X + (size_t)row * 2048 + eb) = (f32x4){ov[0], ov[1], ov[2], ov[3]}; *(f32x4*)(X + (size_t)row * 2048 + eb + 4) = (f32x4){ov[4], ov[5], ov[6], ov[7]};
                    const f32x4 s0 = *(const f32x4*)(mdn + MO_SC1 + eb), s1 = *(const f32x4*)(mdn + MO_SC1 + eb + 4), b0 = *(const f32x4*)(mdn + MO_SH1 + eb), b1 = *(const f32x4*)(mdn + MO_SH1 + eb + 4);
                    u32x4 w; w.x = pk2(ov[0] * (1.f + s0[0]) + b0[0], ov[1] * (1.f + s0[1]) + b0[1]); w.y = pk2(ov[2] * (1.f + s0[2]) + b0[2], ov[3] * (1.f + s0[3]) + b0[3]);
                    w.z = pk2(ov[4] * (1.f + s1[0]) + b1[0], ov[5] * (1.f + s1[1]) + b1[1]); w.w = pk2(ov[6] * (1.f + s1[2]) + b1[2], ov[7] * (1.f + s1[3]) + b1[3]);
                    *(u32x4*)(H + (size_t)row * 2048 + eb) = w;
                } else {
                    float* op = P->out + (size_t)(row - 256) * 2048 + eb;
                    *(f32x4*)op = (f32x4){ov[0], ov[1], ov[2], ov[3]}; *(f32x4*)(op + 4) = (f32x4){ov[4], ov[5], ov[6], ov[7]};
                }
                asm volatile("" ::: "memory");
            }
    }
}

constexpr int NTHREADS = 512;
constexpr int LDS_BYTES = 147456;

__global__ void __launch_bounds__(NTHREADS, 2) fwd_megakernel(Params Pk) {
    extern __shared__ __attribute__((aligned(16))) unsigned char lds_raw[];
    LAS unsigned char* lds = (LAS unsigned char*)lds_raw;
    cg::grid_group grid = cg::this_grid();
    int tid = threadIdx.x, lane = tid & 63, wave = __builtin_amdgcn_readfirstlane(tid >> 6);
    const int G = gridDim.x;
    KP P = (KP)__builtin_amdgcn_kernarg_segment_ptr();

#define PFENCE() do { asm volatile("" : "+s"(P), "+v"(tid) :: "memory"); lane = tid & 63; wave = __builtin_amdgcn_readfirstlane(tid >> 6); } while (0)
    phase_prologue(P, lds, tid, lane, wave);
    grid.sync(); PFENCE();
    phase_mod0(P, lane, wave);
    grid.sync(); PFENCE();

#pragma unroll 1
    for (int l = 0; l < 2; ++l) {
        const int first_row = (l == 0) ? 0 : 256;
        const float* MOD = WSP(float, WS_MOD);
        { pg8::Gemm g{WSP(bf16_t, WS_H), WSP(bf16_t, WS_WIN) + (size_t)l * NPROJ * 2048, TOK, NPROJ, 2048}; pg8::StaticOrder S; S.init(TOK, NPROJ, G, (int)blockIdx.x);
          pg8::EpiBf16 E{WSP(bf16_t, WS_PROJ), NPROJ, 0};
          pg8::gemm_phase<pg8::EpiBf16, pg8::StaticOrder, true, true>(lds, g, S, E); }
        grid.sync(); PFENCE();
        phase_post(P, l, lds, tid);
        grid.sync(); PFENCE();
        for (int u = blockIdx.x; u < NCH * 16; u += G) ssd_states_unit(P, l, u, lds, tid, lane, wave);
        { const int gw = wave * G + blockIdx.x, NGW = G * 8;
          for (int it = gw; it < 4096; it += NGW) attn_item<0>(P, l, it, lane);
          for (int it = gw; it < 4096; it += NGW) attn_item<1>(P, l, it, lane);
          if (l == 0) { for (int it = gw; it < 128; it += NGW) attn_item<2>(P, l, it, lane);
                        for (int it = gw; it < 128; it += NGW) attn_item<3>(P, l, it, lane); } }
        grid.sync(); PFENCE();
        phase_scan(P, tid);
        grid.sync(); PFENCE();
        for (int u = blockIdx.x + (l == 0 ? 0 : 32); u < NCH * 16; u += G) ssd_y_unit(P, l, u, lds, tid, lane, wave);
        grid.sync(); PFENCE();
        phase_ssd_finish(P, l, first_row, lane, wave);
        grid.sync(); PFENCE();
        { const float* rc = (l == 0) ? P->ctx : WSP(float, WS_X); const float* rl = (l == 0) ? P->x : WSP(float, WS_X) + (size_t)256 * 2048;
          pg8::Gemm g{WSP(bf16_t, WS_MIX) + (size_t)first_row * 2048, WSP(bf16_t, WS_WOUT) + (size_t)l * 2048 * 2048, TOK - first_row, 2048, 2048};
          pg8::StaticOrder S; S.init(TOK - first_row, 2048, G, (int)blockIdx.x);
          pg8::EpiRes E{rc, rl, MOD + (l * 2 + 1) * MODW + MO_G1, MOD + (l * 2 + 0) * MODW + MO_G1, WSP(float, WS_R), first_row, ALPHA};
          pg8::gemm_phase<pg8::EpiRes, pg8::StaticOrder, true, true>(lds, g, S, E); }
        grid.sync(); PFENCE();
        phase_ln1(P, l, first_row, lane, wave);
        grid.sync(); PFENCE();
        { pg8::Gemm g{WSP(bf16_t, WS_H) + (size_t)first_row * 2048, WSP(bf16_t, WS_WQ) + (size_t)l * 2048 * 2048, TOK - first_row, 2048, 2048};
          pg8::StaticOrder S; S.init(TOK - first_row, 2048, G, (int)blockIdx.x);
          pg8::EpiBf16 E{WSP(bf16_t, WS_Q), 2048, first_row};
          pg8::gemm_phase<pg8::EpiBf16, pg8::StaticOrder, true, true>(lds, g, S, E); }
        grid.sync(); PFENCE();
        { const int gw = wave * G + blockIdx.x, NGW = G * 8; const int nit = ((TOK - first_row) / 16) * 8;
#ifdef DBG_NAIVE_ROUTE
          (void)gw; (void)NGW; (void)nit; route_naive(P, l, first_row, tid); }
#else
          for (int it = gw; it < nit; it += NGW) route_item(P, l, it, first_row, lds + wave * ROUTE_WAVE_BYTES, lane); }
#endif
        grid.sync(); PFENCE();
#ifdef DBG_NAIVE_EXPERTS
        experts_naive_a(P, l, first_row, tid); grid.sync(); PFENCE(); experts_naive_b(P, l, first_row, tid); grid.sync(); PFENCE();
#endif
        phase_experts(P, l, first_row, lane, wave);
        if (l == 0) { grid.sync(); PFENCE(); }
    }
}

extern "C" void kernel_launch(void* const* d_in, const int* in_sizes, int n_in, void* d_out, int out_size, void* d_ws, size_t ws_size, hipStream_t stream) {
    static int grid_blocks = 0;
    if (grid_blocks == 0) {
        if (n_in != 25 || ws_size < WS_END) { fprintf(stderr, "kernel_launch: unexpected inputs (n_in %d, ws %zu)\n", n_in, ws_size); grid_blocks = -1; return; }
        int dev = 0, cus = 0, per_cu = 0;
        hipGetDevice(&dev); hipDeviceGetAttribute(&cus, hipDeviceAttributeMultiprocessorCount, dev);
        hipFuncSetAttribute((const void*)fwd_megakernel, hipFuncAttributeMaxDynamicSharedMemorySize, LDS_BYTES);
        hipOccupancyMaxActiveBlocksPerMultiprocessor(&per_cu, (const void*)fwd_megakernel, NTHREADS, LDS_BYTES);
        if (per_cu < 1) { fprintf(stderr, "kernel_launch: occupancy query says %d blocks per CU\n", per_cu); per_cu = 1; }
        grid_blocks = cus;
        (void)hipGetLastError();
    }
    if (grid_blocks < 0) return;
    Params p{};
    const float** pp = (const float**)&p;
    for (int i = 0; i < 25; ++i) pp[i] = (const float*)d_in[i];
    p.out = (float*)d_out; p.ws = (unsigned char*)d_ws;
    void* args[] = {&p};
    hipError_t e = hipLaunchCooperativeKernel((const void*)fwd_megakernel, dim3(grid_blocks), dim3(NTHREADS), args, LDS_BYTES, stream);
    if (e != hipSuccess) fprintf(stderr, "cooperative launch failed: %s (grid %d)\n", hipGetErrorString(e), grid_blocks);
}
```
